# Optimizing an MI355X kernel written in HIP

```python
import math
import jax
import jax.numpy as jnp
from jax import lax
import numpy as np

D_MODEL = 1024
BATCH = 4
SEQ = 4096
DEPTH = 4

CHUNK = 64
EPS = 1e-6
D_FF = 2816

SSD_HEADS = 8
SSD_HEAD_DIM = 64
SSD_INNER = SSD_HEADS * SSD_HEAD_DIM
SSD_GROUPS = 2
SSD_STATE = 128
SSD_CONV = 4
SSD_XBC = SSD_INNER + 2 * SSD_GROUPS * SSD_STATE
SSD_HPG = SSD_HEADS // SSD_GROUPS

S5_WIDTH = 512
S5_GROUP = 16
S5_GROUPS = S5_WIDTH // S5_GROUP
S5_STATE = 64

ATT_HEADS = 8
ATT_HEAD_DIM = 64
ATT_WIDTH = ATT_HEADS * ATT_HEAD_DIM
LEFT_CHUNKS = 8
BAND_CHUNKS = LEFT_CHUNKS + 1
BAND = BAND_CHUNKS * CHUNK
MAX_REL = 128

POOL_WINDOWS = (2, 4, 8, 16)
POOL_GROUPS = len(POOL_WINDOWS)
POOL_WIDTH = 512
POOL_GROUP = POOL_WIDTH // POOL_GROUPS
POOL_MAX = max(POOL_WINDOWS)

EVEN_IN = SSD_INNER + SSD_XBC + SSD_HEADS + S5_WIDTH
EVEN_OUT = SSD_INNER + S5_WIDTH
ODD_IN = 3 * ATT_WIDTH + POOL_WIDTH
ODD_OUT = ATT_WIDTH + POOL_WIDTH
N_EVEN = (DEPTH + 1) // 2
N_ODD = DEPTH // 2

kernel_name = 'hybrid_chunk_causal_encoder'


def _rmsnorm(x, gain):
    xf = x.astype(jnp.float32)
    y = xf * lax.rsqrt(jnp.mean(xf * xf, axis=-1, keepdims=True) + EPS)
    return (y * gain.astype(jnp.float32)).astype(x.dtype)


def _swiglu(h, w_gate, w_up, w_down):
    return (jax.nn.silu(h @ w_gate) * (h @ w_up)) @ w_down


def _causal_depthwise_conv(x, w, b):
    c = x.shape[-1]
    y = lax.conv_general_dilated(
        x.astype(jnp.float32), w.astype(jnp.float32)[:, None, :],
        window_strides=(1,), padding=[(SSD_CONV - 1, 0)],
        dimension_numbers=('NWC', 'WIO', 'NWC'), feature_group_count=c)
    return y + b.astype(jnp.float32)


def _ssd_mixer(zxbcdt, conv_w, conv_b, dt_bias, a_log, d_skip, norm_gain):
    f32 = jnp.float32
    bsz, s, _ = zxbcdt.shape
    nc = s // CHUNK
    z, xbc, dt = jnp.split(zxbcdt, [SSD_INNER, SSD_INNER + SSD_XBC], axis=-1)
    xbc = jax.nn.silu(_causal_depthwise_conv(xbc, conv_w, conv_b))
    xs, bm, cm = jnp.split(xbc, [SSD_INNER, SSD_INNER + SSD_GROUPS * SSD_STATE], axis=-1)
    xs = xs.reshape(bsz, nc, CHUNK, SSD_GROUPS, SSD_HPG, SSD_HEAD_DIM)
    bm = bm.reshape(bsz, nc, CHUNK, SSD_GROUPS, SSD_STATE)
    cm = cm.reshape(bsz, nc, CHUNK, SSD_GROUPS, SSD_STATE)
    dt = jax.nn.softplus(dt.astype(f32) + dt_bias.astype(f32))
    dt = dt.reshape(bsz, nc, CHUNK, SSD_GROUPS, SSD_HPG)
    a = -jnp.exp(a_log.astype(f32)).reshape(SSD_GROUPS, SSD_HPG)
    a_cs = jnp.cumsum(dt * a, axis=2)
    xdt = xs * dt[..., None]
    causal = jnp.tril(jnp.ones((CHUNK, CHUNK), dtype=bool))[:, :, None, None]
    seg = a_cs[:, :, :, None] - a_cs[:, :, None, :]
    decay = jnp.exp(jnp.where(causal, seg, -jnp.inf))
    cb = jnp.einsum('bclgn,bcsgn->bclsg', cm, bm)
    y_diag = jnp.einsum('bclsg,bclsgj,bcsgjp->bclgjp', cb, decay, xdt)
    to_end = jnp.exp(a_cs[:, :, -1:] - a_cs)
    states = jnp.einsum('bclgn,bclgj,bclgjp->bcgjpn', bm, to_end, xdt)
    chunk_decay = jnp.exp(a_cs[:, :, -1])

    def step(h, inp):
        st, dec = inp
        return dec[..., None, None] * h + st, h

    h0 = jnp.zeros((bsz, SSD_GROUPS, SSD_HPG, SSD_HEAD_DIM, SSD_STATE), f32)
    _, h_prev = lax.scan(step, h0, (jnp.moveaxis(states, 1, 0), jnp.moveaxis(chunk_decay, 1, 0)))
    h_prev = jnp.moveaxis(h_prev, 0, 1)
    y_off = jnp.einsum('bclgn,bcgjpn,bclgj->bclgjp', cm, h_prev, jnp.exp(a_cs))
    y = y_diag + y_off + d_skip.astype(f32).reshape(SSD_GROUPS, SSD_HPG, 1) * xs
    y = y.reshape(bsz, s, SSD_INNER) * jax.nn.silu(z.astype(f32))
    yg = y.reshape(bsz, s, SSD_GROUPS, SSD_INNER // SSD_GROUPS)
    yg = yg * lax.rsqrt(jnp.mean(yg * yg, axis=-1, keepdims=True) + EPS)
    return (yg.reshape(bsz, s, SSD_INNER) * norm_gain.astype(f32)).astype(zxbcdt.dtype)


def _complex_affine_combine(e1, e2):
    a1r, a1i, x1r, x1i = e1
    a2r, a2i, x2r, x2i = e2
    return (a2r * a1r - a2i * a1i,
            a2r * a1i + a2i * a1r,
            a2r * x1r - a2i * x1i + x2r,
            a2r * x1i + a2i * x1r + x2i)


def _s5_mixer(u, a_re, a_im, log_dt, b_re, b_im, c_re, c_im, d_skip, w_glu, b_glu):
    f32 = jnp.float32
    bsz, s, _ = u.shape
    uf = u.astype(f32).reshape(bsz, s, S5_GROUPS, S5_GROUP)
    ar = a_re.astype(f32)
    ai = a_im.astype(f32)
    dt = jnp.exp(log_dt.astype(f32))[:, None]
    mag = jnp.exp(dt * ar)
    abar_re = mag * jnp.cos(dt * ai)
    abar_im = mag * jnp.sin(dt * ai)
    den = ar * ar + ai * ai
    f_re = ((abar_re - 1.0) * ar + abar_im * ai) / den
    f_im = (abar_im * ar - (abar_re - 1.0) * ai) / den
    br = b_re.astype(f32)
    bi = b_im.astype(f32)
    bb_re = f_re[..., None] * br - f_im[..., None] * bi
    bb_im = f_re[..., None] * bi + f_im[..., None] * br
    drive_re = jnp.einsum('bsgi,gpi->sbgp', uf, bb_re)
    drive_im = jnp.einsum('bsgi,gpi->sbgp', uf, bb_im)
    shape_a = (s, 1, S5_GROUPS, S5_STATE)
    dec_re = jnp.broadcast_to(abar_re, shape_a)
    dec_im = jnp.broadcast_to(abar_im, shape_a)
    _, _, h_re, h_im = lax.associative_scan(
        _complex_affine_combine, (dec_re, dec_im, drive_re, drive_im), axis=0)
    y = (jnp.einsum('gip,sbgp->bsgi', c_re.astype(f32), h_re)
         - jnp.einsum('gip,sbgp->bsgi', c_im.astype(f32), h_im)
         + d_skip.astype(f32) * uf)
    y = y.reshape(bsz, s, S5_WIDTH)
    gate = jax.nn.gelu(y) @ w_glu.astype(f32) + b_glu.astype(f32)
    return (y * jax.nn.sigmoid(gate)).astype(u.dtype)


def _chunk_band_attention(q, k, v, q_gain, k_gain, rel_bias):
    f32 = jnp.float32
    bsz, s, _ = q.shape
    nc = s // CHUNK
    q = _rmsnorm(q.reshape(bsz, nc, CHUNK, ATT_HEADS, ATT_HEAD_DIM), q_gain)
    k = _rmsnorm(k.reshape(bsz, s, ATT_HEADS, ATT_HEAD_DIM), k_gain)
    v = v.reshape(bsz, s, ATT_HEADS, ATT_HEAD_DIM)
    front = ((0, 0), (LEFT_CHUNKS * CHUNK, 0), (0, 0), (0, 0))
    kp = jnp.pad(k, front).reshape(bsz, nc + LEFT_CHUNKS, CHUNK, ATT_HEADS, ATT_HEAD_DIM)
    vp = jnp.pad(v, front).reshape(bsz, nc + LEFT_CHUNKS, CHUNK, ATT_HEADS, ATT_HEAD_DIM)
    band_idx = jnp.arange(nc)[:, None] + jnp.arange(BAND_CHUNKS)[None, :]
    kb = kp[:, band_idx].reshape(bsz, nc, BAND, ATT_HEADS, ATT_HEAD_DIM)
    vb = vp[:, band_idx].reshape(bsz, nc, BAND, ATT_HEADS, ATT_HEAD_DIM)
    scores = jnp.einsum('bclhd,bckhd->bhclk', q.astype(f32), kb.astype(f32)) * (ATT_HEAD_DIM ** -0.5)
    q_off = LEFT_CHUNKS * CHUNK + jnp.arange(CHUNK)
    dist = q_off[:, None] - jnp.arange(BAND)[None, :]
    bias = rel_bias.astype(f32)[:, jnp.clip(dist, -MAX_REL, MAX_REL) + MAX_REL]
    valid = jnp.repeat(band_idx >= LEFT_CHUNKS, CHUNK, axis=1)
    scores = jnp.where(valid[None, None, :, None, :], scores + bias[None, :, None], -jnp.inf)
    probs = jax.nn.softmax(scores, axis=-1)
    out = jnp.einsum('bhclk,bckhd->bclhd', probs, vb.astype(f32))
    return out.reshape(bsz, s, ATT_WIDTH).astype(q.dtype)


def _multiscale_pool(u, w_pool, scale):
    f32 = jnp.float32
    bsz, s, _ = u.shape
    uf = u.astype(f32).reshape(bsz, s, POOL_GROUPS, POOL_GROUP)
    csum = jnp.pad(jnp.cumsum(uf, axis=1), ((0, 0), (POOL_MAX, 0), (0, 0), (0, 0)))
    pos = jnp.arange(s)
    means = []
    for g, w in enumerate(POOL_WINDOWS):
        win = csum[:, POOL_MAX:, g] - csum[:, POOL_MAX - w:POOL_MAX - w + s, g]
        count = jnp.minimum(pos + 1, w).astype(f32)[None, :, None]
        means.append(win / count)
    pooled = jnp.stack(means, axis=2) - uf
    y = jnp.einsum('bsgi,gio->bsgo', pooled, w_pool.astype(f32)).reshape(bsz, s, POOL_WIDTH)
    return (y * scale.astype(f32)).astype(u.dtype)


def setup_inputs(seed: int = 0) -> dict:
    key = jax.random.key(seed)
    keys = iter(jax.random.split(key, 48))
    f32 = jnp.float32

    def normal(shape, scale):
        return scale * jax.random.normal(next(keys), shape, f32)

    def gain(shape):
        return 1.0 + 0.05 * jax.random.normal(next(keys), shape, f32)

    def log_uniform(shape, lo, hi):
        return jax.random.uniform(next(keys), shape, f32, math.log(lo), math.log(hi))

    ssd_dt = jnp.exp(log_uniform((N_EVEN, SSD_HEADS), 1e-3, 1e-1))
    ssd_dt_bias = ssd_dt + jnp.log(-jnp.expm1(-ssd_dt))
    ssd_a_log = jnp.log(jax.random.uniform(next(keys), (N_EVEN, SSD_HEADS), f32, 1.0, 16.0))
    s5_shape = (N_EVEN, S5_GROUPS, S5_STATE)
    s5_a_re = -0.5 + normal(s5_shape, 0.01)
    s5_a_im = math.pi * jnp.arange(S5_STATE, dtype=f32) + normal(s5_shape, 0.01)
    s5_log_dt = log_uniform((N_EVEN, S5_GROUPS), 1e-3, 1e-1)
    return {
        'x': normal((BATCH, SEQ, D_MODEL), 1.0),
        'ffn1_norm': gain((DEPTH, D_MODEL)),
        'ffn1_w_gate': normal((DEPTH, D_MODEL, D_FF), D_MODEL ** -0.5),
        'ffn1_w_up': normal((DEPTH, D_MODEL, D_FF), D_MODEL ** -0.5),
        'ffn1_w_down': normal((DEPTH, D_FF, D_MODEL), D_FF ** -0.5),
        'mix_norm': gain((DEPTH, D_MODEL)),
        'even_w_in': normal((N_EVEN, D_MODEL, EVEN_IN), D_MODEL ** -0.5),
        'even_w_out': normal((N_EVEN, EVEN_OUT, D_MODEL), EVEN_OUT ** -0.5),
        'ssd_conv_w': normal((N_EVEN, SSD_CONV, SSD_XBC), SSD_CONV ** -0.5),
        'ssd_conv_b': normal((N_EVEN, SSD_XBC), 0.02),
        'ssd_dt_bias': ssd_dt_bias,
        'ssd_a_log': ssd_a_log,
        'ssd_d': gain((N_EVEN, SSD_HEADS)),
        'ssd_norm': gain((N_EVEN, SSD_INNER)),
        's5_a_re': s5_a_re,
        's5_a_im': s5_a_im,
        's5_log_dt': s5_log_dt,
        's5_b_re': normal((N_EVEN, S5_GROUPS, S5_STATE, S5_GROUP), (2 * S5_GROUP) ** -0.5),
        's5_b_im': normal((N_EVEN, S5_GROUPS, S5_STATE, S5_GROUP), (2 * S5_GROUP) ** -0.5),
        's5_c_re': normal((N_EVEN, S5_GROUPS, S5_GROUP, S5_STATE), S5_STATE ** -0.5),
        's5_c_im': normal((N_EVEN, S5_GROUPS, S5_GROUP, S5_STATE), S5_STATE ** -0.5),
        's5_d': normal((N_EVEN, S5_GROUPS, S5_GROUP), 1.0),
        's5_w_glu': normal((N_EVEN, S5_WIDTH, S5_WIDTH), S5_WIDTH ** -0.5),
        's5_b_glu': normal((N_EVEN, S5_WIDTH), 0.02),
        'odd_w_in': normal((N_ODD, D_MODEL, ODD_IN), D_MODEL ** -0.5),
        'odd_w_out': normal((N_ODD, ODD_OUT, D_MODEL), ODD_OUT ** -0.5),
        'attn_q_norm': gain((N_ODD, ATT_HEAD_DIM)),
        'attn_k_norm': gain((N_ODD, ATT_HEAD_DIM)),
        'attn_rel_bias': normal((N_ODD, ATT_HEADS, 2 * MAX_REL + 1), 0.1),
        'pool_w': normal((N_ODD, POOL_GROUPS, POOL_GROUP, POOL_GROUP), POOL_GROUP ** -0.5),
        'pool_scale': gain((N_ODD, POOL_WIDTH)),
        'ffn2_norm': gain((DEPTH, D_MODEL)),
        'ffn2_w_gate': normal((DEPTH, D_MODEL, D_FF), D_MODEL ** -0.5),
        'ffn2_w_up': normal((DEPTH, D_MODEL, D_FF), D_MODEL ** -0.5),
        'ffn2_w_down': normal((DEPTH, D_FF, D_MODEL), D_FF ** -0.5),
    }


def reference(x, ffn1_norm, ffn1_w_gate, ffn1_w_up, ffn1_w_down, mix_norm,
              even_w_in, even_w_out, ssd_conv_w, ssd_conv_b, ssd_dt_bias, ssd_a_log, ssd_d, ssd_norm,
              s5_a_re, s5_a_im, s5_log_dt, s5_b_re, s5_b_im, s5_c_re, s5_c_im, s5_d, s5_w_glu, s5_b_glu,
              odd_w_in, odd_w_out, attn_q_norm, attn_k_norm, attn_rel_bias, pool_w, pool_scale,
              ffn2_norm, ffn2_w_gate, ffn2_w_up, ffn2_w_down):
    for layer in range(DEPTH):
        i = layer // 2
        h = _rmsnorm(x, ffn1_norm[layer])
        x = x + 0.5 * _swiglu(h, ffn1_w_gate[layer], ffn1_w_up[layer], ffn1_w_down[layer])
        h = _rmsnorm(x, mix_norm[layer])
        if layer % 2 == 0:
            proj = h @ even_w_in[i]
            zxbcdt, u = jnp.split(proj, [SSD_INNER + SSD_XBC + SSD_HEADS], axis=-1)
            y_a = _ssd_mixer(zxbcdt, ssd_conv_w[i], ssd_conv_b[i], ssd_dt_bias[i],
                             ssd_a_log[i], ssd_d[i], ssd_norm[i])
            y_b = _s5_mixer(u, s5_a_re[i], s5_a_im[i], s5_log_dt[i], s5_b_re[i], s5_b_im[i],
                            s5_c_re[i], s5_c_im[i], s5_d[i], s5_w_glu[i], s5_b_glu[i])
            mixed = jnp.concatenate([y_a, y_b], axis=-1).astype(x.dtype) @ even_w_out[i]
        else:
            proj = h @ odd_w_in[i]
            q, k, v, u = jnp.split(proj, [ATT_WIDTH, 2 * ATT_WIDTH, 3 * ATT_WIDTH], axis=-1)
            y_c = _chunk_band_attention(q, k, v, attn_q_norm[i], attn_k_norm[i], attn_rel_bias[i])
            y_d = _multiscale_pool(u, pool_w[i], pool_scale[i])
            mixed = jnp.concatenate([y_c, y_d], axis=-1).astype(x.dtype) @ odd_w_out[i]
        x = x + mixed.astype(x.dtype)
        h = _rmsnorm(x, ffn2_norm[layer])
        x = x + 0.5 * _swiglu(h, ffn2_w_gate[layer], ffn2_w_up[layer], ffn2_w_down[layer])
    return x
```

```cpp
#include <hip/hip_runtime.h>
#include <hip/hip_cooperative_groups.h>
#include <cstdio>
namespace cg = cooperative_groups;

#define LAS __attribute__((address_space(3)))
typedef float f32x2 __attribute__((ext_vector_type(2)));
typedef unsigned u32x2 __attribute__((ext_vector_type(2)));

namespace pg8 {
#define PG8_LAS __attribute__((address_space(3)))
typedef unsigned short bf16_t;
typedef short bf16x8 __attribute__((ext_vector_type(8)));
typedef float f32x4 __attribute__((ext_vector_type(4)));
typedef unsigned u32x4 __attribute__((ext_vector_type(4)));
constexpr int BM = 256, BK = 64, HALF = 128, HTB = HALF * BK * 2  , STAGE_BYTES = 8 * HTB, NXCD = 8, WGM = 8;

__host__ __device__ __forceinline__ int lds_byte(int r, int c) { const int st = (r >> 4) * 2 + (c >> 5), rr = r & 15, cc = c & 31, ob = rr * 64 + cc * 2; return st * 1024 + (ob ^ (((ob >> 9) & 1) << 5)); }
__host__ __device__ __forceinline__ void stage_rc(int b, int& R, int& C) { const int st = b / 1024, sb = b % 1024, swz = sb ^ (((sb >> 9) & 1) << 5); R = (st >> 1) * 16 + swz / 64; C = (st & 1) * 32 + (swz % 64) / 2; }
__host__ __device__ __forceinline__ int perm32(int rho) { const int n = rho >> 4, i = rho & 15; return 8 * (i >> 2) + 4 * n + (i & 3); }

struct Unit { int pm, pn; };
struct Gemm { const bf16_t* A; const bf16_t* Bt; int M, N, K; };

struct StaticOrder {
    int nM, nN, nwg, G, c;
    __host__ __device__ void init(int M, int N, int G_, int c_) { nM = M / BM; nN = N / BM; nwg = nM * nN; G = G_; c = c_; }
    __host__ __device__ bool next(int i, Unit& u) const {
        const long L = (long)i * G + c; if (L >= nwg) return false;
        int wgid = (int)L; { const int q = nwg / NXCD, r = nwg % NXCD, xcd = wgid % NXCD, off = wgid / NXCD; wgid = (xcd < r ? xcd * (q + 1) : r * (q + 1) + (xcd - r) * q) + off; }
        const int nig = WGM * nN, gid = wgid / nig, fm = gid * WGM, gsz = (nM - fm) < WGM ? (nM - fm) : WGM;
        u.pm = fm + ((wgid % nig) % gsz); u.pn = (wgid % nig) / gsz; return true;
    }
    __device__ __forceinline__ void a_ready(const Unit&) const {}
    __device__ __forceinline__ void done(const Unit&) const {}
};
template <class Epi, class Sched, bool STAMP = false>
__device__ __forceinline__ void gemm_phase(PG8_LAS unsigned char* lds, const Gemm g, const Sched& S, const Epi& E, unsigned long long* stamps) {
    int tid_l = threadIdx.x; asm volatile("" : "+v"(tid_l));
    const int tid = tid_l, wid = __builtin_amdgcn_readfirstlane(tid >> 6), lane = tid & 63, wr = wid >> 2, wc = wid & 3, fr = lane & 15, fq = lane >> 4;
    const int K = g.K, nt = K / BK;
    int ts_lo = 0, ts_hi = 0, nts = 0; const unsigned long long rt_entry = STAMP ? (unsigned long long)wall_clock64() : 0ull;
#define PG8_STAMP() do { if (STAMP && wid == 0 && nts < 64) { const unsigned long long _c = (unsigned long long)clock64(); \
        ts_lo = (lane == nts) ? (int)(unsigned)_c : ts_lo; ts_hi = (lane == nts) ? (int)(unsigned)(_c >> 32) : ts_hi; ++nts; } } while (0)
    PG8_STAMP();
    unsigned voffA[2], voffB[2];
#pragma unroll
    for (int i = 0; i < 2; ++i) { int R, C; stage_rc(tid * 16 + i * 8192, R, C); const int Rb = Epi::PERM ? ((R & ~31) + perm32(R & 31)) : R;
        voffA[i] = (unsigned)(R * K + C) * 2u; voffB[i] = (unsigned)(Rb * K + C) * 2u; }
    const size_t kstep = (size_t)(BK * 2);
    const size_t hstep = (size_t)HALF * K * 2;
    const size_t tstep = 2 * hstep;
    const unsigned ldsw = (unsigned)wid * 1024u;
    const int aoff = lds_byte(wr * 64 + fr, fq * 8), boff = lds_byte(wc * 32 + fr, fq * 8);
#define PG8_SA(b, h) (((b) * 2 + (h)) * HTB)
#define PG8_SB(b, h) ((4 + (b) * 2 + (h)) * HTB)
#define PG8_STAGE(bufoff, gbase, voff) do { _Pragma("unroll") for (int _i = 0; _i < 2; ++_i) \
        __builtin_amdgcn_global_load_lds((const unsigned*)((const char*)(gbase) + (voff)[_i]), (PG8_LAS unsigned*)(lds + (bufoff) + ldsw + _i * 8192), 16, 0, 0); } while (0)
#define PG8_LDA(dst, b, h) do { _Pragma("unroll") for (int m = 0; m < 4; ++m) _Pragma("unroll") for (int k = 0; k < 2; ++k) dst[m][k] = *(const PG8_LAS bf16x8*)(lds + PG8_SA(b, h) + aoff + m * 2048 + k * 1024); } while (0)
#define PG8_LDB(dst, b, h) do { _Pragma("unroll") for (int n = 0; n < 2; ++n) _Pragma("unroll") for (int k = 0; k < 2; ++k) dst[n][k] = *(const PG8_LAS bf16x8*)(lds + PG8_SB(b, h) + boff + n * 2048 + k * 1024); } while (0)
#define PG8_MMA(ai, bj, At, Bt) do { __builtin_amdgcn_s_setprio(1); _Pragma("unroll") for (int m = 0; m < 4; ++m) _Pragma("unroll") for (int n = 0; n < 2; ++n) _Pragma("unroll") for (int k = 0; k < 2; ++k) \
        acc[ai][bj][m][n] = __builtin_amdgcn_mfma_f32_16x16x32_bf16(Bt[n][k], At[m][k], acc[ai][bj][m][n], 0, 0, 0); __builtin_amdgcn_s_setprio(0); } while (0)
#define PG8_WAIT_V(n) asm volatile("s_waitcnt vmcnt(" #n ")" ::: "memory")
#define PG8_WAIT_L(n) asm volatile("s_waitcnt lgkmcnt(" #n ")" ::: "memory")
#define PG8_BAR __builtin_amdgcn_s_barrier()
#define PG8_SCHED __builtin_amdgcn_sched_barrier(0)
    Unit cur, nxt; int ui = 0;
    if (!S.next(0, cur)) return;
    f32x4 acc[2][2][4][2];
#pragma unroll
    for (int a = 0; a < 2; ++a)
#pragma unroll
        for (int b = 0; b < 2; ++b)
#pragma unroll
            for (int m = 0; m < 4; ++m)
#pragma unroll
                for (int n = 0; n < 2; ++n) acc[a][b][m][n] = (f32x4){0.f, 0.f, 0.f, 0.f};
    bf16x8 At[4][2], B0[2][2], B1[2][2];
    const char* cA = (const char*)g.A + (size_t)cur.pm * tstep; const char* cB = (const char*)g.Bt + (size_t)cur.pn * tstep;
    S.a_ready(cur);
    PG8_STAGE(PG8_SB(0, 0), cB, voffB); PG8_STAGE(PG8_SA(0, 0), cA, voffA); PG8_STAGE(PG8_SB(0, 1), cB + hstep, voffB); PG8_STAGE(PG8_SA(0, 1), cA + hstep, voffA);
    if (wr == 1) PG8_BAR;
    PG8_WAIT_V(4); PG8_BAR;
    PG8_STAGE(PG8_SB(1, 0), cB + kstep, voffB); PG8_STAGE(PG8_SA(1, 0), cA + kstep, voffA); PG8_STAGE(PG8_SB(1, 1), cB + hstep + kstep, voffB);
    PG8_WAIT_V(6); PG8_BAR;
    PG8_STAMP();
    for (;;) {
        const bool has_next = S.next(ui + 1, nxt);
        const char* nA = has_next ? (const char*)g.A + (size_t)nxt.pm * tstep : cA; const char* nB = has_next ? (const char*)g.Bt + (size_t)nxt.pn * tstep : cB;
        for (int t = 0; t < nt; t += 2) {
            const bool last = (t == nt - 2);
            const char* a1 = cA + (size_t)(t + 1) * kstep;
            const char* a2 = last ? nA : cA + (size_t)(t + 2) * kstep; const char* b2 = last ? nB : cB + (size_t)(t + 2) * kstep;
            const char* a3 = a2 + kstep; const char* b3 = b2 + kstep;
            if (last && has_next) S.a_ready(nxt);
            PG8_LDB(B0, 0, 0); PG8_SCHED; PG8_LDA(At, 0, 0); PG8_STAGE(PG8_SA(1, 1), a1 + hstep, voffA);
            PG8_WAIT_L(8); PG8_BAR; PG8_WAIT_L(0); PG8_MMA(0, 0, At, B0); PG8_BAR; PG8_SCHED;
            PG8_LDB(B1, 0, 1); PG8_STAGE(PG8_SB(0, 0), b2, voffB);
            PG8_BAR; PG8_WAIT_L(0); PG8_MMA(0, 1, At, B1); PG8_BAR;
            PG8_LDA(At, 0, 1); PG8_STAGE(PG8_SA(0, 0), a2, voffA);
            PG8_BAR; PG8_WAIT_L(0); PG8_MMA(1, 0, At, B0); PG8_BAR; PG8_SCHED;
            PG8_STAGE(PG8_SB(0, 1), b2 + hstep, voffB);
            PG8_WAIT_V(6); PG8_BAR; PG8_MMA(1, 1, At, B1); PG8_BAR;
            PG8_LDB(B0, 1, 0); PG8_SCHED; PG8_LDA(At, 1, 0); PG8_STAGE(PG8_SA(0, 1), a2 + hstep, voffA);
            PG8_WAIT_L(8); PG8_BAR; PG8_WAIT_L(0); PG8_MMA(0, 0, At, B0); PG8_BAR; PG8_SCHED;
            PG8_LDB(B1, 1, 1); PG8_STAGE(PG8_SB(1, 0), b3, voffB);
            PG8_BAR; PG8_WAIT_L(0); PG8_MMA(0, 1, At, B1); PG8_BAR;
            PG8_LDA(At, 1, 1); PG8_STAGE(PG8_SA(1, 0), a3, voffA);
            PG8_BAR; PG8_WAIT_L(0); PG8_MMA(1, 0, At, B0); PG8_BAR; PG8_SCHED;
            PG8_STAGE(PG8_SB(1, 1), b3 + hstep, voffB);
            PG8_WAIT_V(6); PG8_BAR; PG8_MMA(1, 1, At, B1); PG8_BAR;
        }
        PG8_STAMP();
        if constexpr (!Epi::AFTER_DRAIN) { E(acc, cur, wr, wc, fr, fq); S.done(cur); }
        PG8_STAMP();
        if (!has_next) break;
#pragma unroll
        for (int a = 0; a < 2; ++a)
#pragma unroll
            for (int b = 0; b < 2; ++b)
#pragma unroll
                for (int m = 0; m < 4; ++m)
#pragma unroll
                    for (int n = 0; n < 2; ++n) acc[a][b][m][n] = (f32x4){0.f, 0.f, 0.f, 0.f};
        cur = nxt; cA = nA; cB = nB; ++ui;
    }
    PG8_WAIT_V(0);
    if (wr == 0) PG8_BAR;
    PG8_BAR;
    if constexpr (Epi::AFTER_DRAIN) { E.fused(acc, cur, wr, wc, fr, fq, lds, wid, lane); S.done(cur); }
    PG8_STAMP();
    if (STAMP && wid == 0) { stamps[lane] = lane < nts ? (((unsigned long long)(unsigned)ts_hi << 32) | (unsigned)ts_lo) : 0ull;
        if (lane == 62) stamps[62] = rt_entry; if (lane == 63) stamps[63] = (unsigned long long)wall_clock64(); }
#undef PG8_STAMP
#undef PG8_SA
#undef PG8_SB
#undef PG8_STAGE
#undef PG8_LDA
#undef PG8_LDB
#undef PG8_MMA
#undef PG8_WAIT_V
#undef PG8_WAIT_L
#undef PG8_BAR
#undef PG8_SCHED
}
}
using pg8::bf16_t; using pg8::bf16x8; using pg8::f32x4; using pg8::u32x4;

constexpr int T_TOK = 16384, DM = 1024, FF = 2816, SEQ = 4096, NCH = 64;
constexpr float EPS = 1e-6f;
constexpr int LDP_E = 2056, LDP_O = 2048;
constexpr size_t OFF_GU1 = 0, OFF_D1 = 11534336, OFF_GU2 = 17301504, OFF_D2 = 28835840, OFF_WIN = 34603008, OFF_WOUT = 39321600, OFF_WX = 41418752;
constexpr size_t WS_XB = 41943040, WS_R1 = 75497472, WS_MIXED = 210239488, WS_U2 = 243793920, WS_HBF = 310902784, WS_S5E = 344457216, WS_SS = 348651520, WS_CDEC = 349503488, WS_END = 349511680;
constexpr int LDS_BYTES = 131072;

struct Params { const float* in[35]; float* out; unsigned char* ws; int ph_lo, ph_hi; };
typedef const float* cfp_t;
__device__ __forceinline__ const float* inp(int k) { asm volatile("" : "+s"(k)); return ((const __attribute__((address_space(4))) cfp_t*)__builtin_amdgcn_kernarg_segment_ptr())[k]; }
struct Ctx { float* out; unsigned char* ws; int tid, bid, G; };

__device__ __forceinline__ unsigned pk_bf16(float lo, float hi) { unsigned r; asm("v_cvt_pk_bf16_f32 %0, %1, %2" : "=v"(r) : "v"(lo), "v"(hi)); return r; }
__device__ __forceinline__ float bf_lo(unsigned w) { return __uint_as_float(w << 16); }
__device__ __forceinline__ float bf_hi(unsigned w) { return __uint_as_float(w & 0xffff0000u); }
__device__ __forceinline__ float silu_f(float v) { return v * __builtin_amdgcn_rcpf(1.0f + __expf(-v)); }
__device__ __forceinline__ f32x4 mfma16(bf16x8 a, bf16x8 b, f32x4 c) { return __builtin_amdgcn_mfma_f32_16x16x32_bf16(a, b, c, 0, 0, 0); }
__device__ __forceinline__ bf16x8 as_bf16x8(u32x4 w) { return __builtin_bit_cast(bf16x8, w); }
__device__ __forceinline__ u32x4 as_u32x4(bf16x8 w) { return __builtin_bit_cast(u32x4, w); }

struct EpiGateUp {
    static constexpr bool PERM = true, AFTER_DRAIN = false;
    bf16_t* O; const float* ss;
    __device__ __forceinline__ void operator()(const f32x4 (&acc)[2][2][4][2], const pg8::Unit& u, int wr, int wc, int fr, int fq) const {
        const int row0 = u.pm * 256 + wr * 64 + fr, col0 = u.pn * 128 + wc * 32 + 8 * fq;
#pragma unroll
        for (int ai = 0; ai < 2; ++ai)
#pragma unroll
            for (int m = 0; m < 4; ++m) {
                const int r = row0 + ai * 128 + m * 16;
                const f32x4 sp = *(const f32x4*)(ss + (size_t)r * 4); const float rs = rsqrtf(((sp[0] + sp[1]) + (sp[2] + sp[3])) * (1.0f / 1024.0f) + EPS);
                float a[8];
#pragma unroll
                for (int n = 0; n < 2; ++n)
#pragma unroll
                    for (int j = 0; j < 4; ++j) { const float g = acc[ai][0][m][n][j] * rs, up = acc[ai][1][m][n][j] * rs; a[n * 4 + j] = silu_f(g) * up; }
                u32x4 w; w.x = pk_bf16(a[0], a[1]); w.y = pk_bf16(a[2], a[3]); w.z = pk_bf16(a[4], a[5]); w.w = pk_bf16(a[6], a[7]);
                *(u32x4*)(O + (size_t)r * FF + col0) = w;
            }
    }
};
struct EpiResid {
    static constexpr bool PERM = false, AFTER_DRAIN = true;
    float* x; bf16_t* xb; float* ssn; float scale;
    __device__ __forceinline__ void fused(f32x4 (&acc)[2][2][4][2], const pg8::Unit& u, int wr, int wc, int fr, int fq, LAS unsigned char* lds, int wid, int lane) const {
        const int row0 = u.pm * 256 + wr * 64 + fr, col0 = u.pn * 256 + wc * 32 + 4 * fq;
        LAS float* Pq = (LAS float*)lds;
#pragma unroll
        for (int ai = 0; ai < 2; ++ai)
#pragma unroll
            for (int m = 0; m < 4; ++m) {
                const int r = row0 + ai * 128 + m * 16; float q = 0.f;
#pragma unroll
                for (int bj = 0; bj < 2; ++bj)
#pragma unroll
                    for (int n = 0; n < 2; ++n) {
                        const size_t o = (size_t)r * DM + col0 + bj * 128 + n * 16;
                        f32x4 v = *(const f32x4*)(x + o); v += acc[ai][bj][m][n] * scale;
                        *(f32x4*)(x + o) = v;
                        u32x2 w; w.x = pk_bf16(v[0], v[1]); w.y = pk_bf16(v[2], v[3]); *(u32x2*)(xb + o) = w;
                        q += (v[0] * v[0] + v[1] * v[1]) + (v[2] * v[2] + v[3] * v[3]);
                    }
                q += __shfl_xor(q, 16); q += __shfl_xor(q, 32);
                if (fq == 0) Pq[(ai * 128 + wr * 64 + m * 16 + fr) * 4 + wc] = q;
            }
        asm volatile("s_waitcnt lgkmcnt(0)" ::: "memory"); __builtin_amdgcn_s_barrier(); asm volatile("" ::: "memory");
        const int t = wid * 64 + lane;
        if (t < 256) { const f32x4 p = *(const LAS f32x4*)(Pq + t * 4); ssn[(size_t)(u.pm * 256 + t) * 4 + u.pn] = (p[0] + p[1]) + (p[2] + p[3]); }
    }
};
struct EpiProj {
    static constexpr bool PERM = false, AFTER_DRAIN = false;
    float* O; const float* ss; int ld, ncv;
    __device__ __forceinline__ void operator()(const f32x4 (&acc)[2][2][4][2], const pg8::Unit& u, int wr, int wc, int fr, int fq) const {
        const int row0 = u.pm * 256 + wr * 64 + fr, col0 = u.pn * 256 + wc * 32 + 4 * fq;
#pragma unroll
        for (int ai = 0; ai < 2; ++ai)
#pragma unroll
            for (int m = 0; m < 4; ++m) {
                const int r = row0 + ai * 128 + m * 16;
                const f32x4 sp = *(const f32x4*)(ss + (size_t)r * 4); const float rs = rsqrtf(((sp[0] + sp[1]) + (sp[2] + sp[3])) * (1.0f / 1024.0f) + EPS);
#pragma unroll
                for (int bj = 0; bj < 2; ++bj)
#pragma unroll
                    for (int n = 0; n < 2; ++n) { const int c = col0 + bj * 128 + n * 16; if (c < ncv) *(f32x4*)(O + (size_t)r * ld + c) = acc[ai][bj][m][n] * rs; }
            }
    }
};
struct EpiGlu {
    static constexpr bool PERM = true, AFTER_DRAIN = false;
    bf16_t* O; const float* ys; const float* bias;
    __device__ __forceinline__ void operator()(const f32x4 (&acc)[2][2][4][2], const pg8::Unit& u, int wr, int wc, int fr, int fq) const {
        const int row0 = u.pm * 256 + wr * 64 + fr, col0 = u.pn * 256 + wc * 32 + 8 * fq;
#pragma unroll
        for (int ai = 0; ai < 2; ++ai)
#pragma unroll
            for (int m = 0; m < 4; ++m) {
                const int r = row0 + ai * 128 + m * 16;
#pragma unroll
                for (int bj = 0; bj < 2; ++bj) {
                    const int c = col0 + bj * 128; float a[8];
#pragma unroll
                    for (int n = 0; n < 2; ++n) {
                        const f32x4 bv = *(const f32x4*)(bias + c + 4 * n), yv = *(const f32x4*)(ys + (size_t)r * 512 + c + 4 * n);
#pragma unroll
                        for (int j = 0; j < 4; ++j) { const float gt = acc[ai][bj][m][n][j] + bv[j]; a[n * 4 + j] = yv[j] * __builtin_amdgcn_rcpf(1.0f + __expf(-gt)); }
                    }
                    u32x4 w; w.x = pk_bf16(a[0], a[1]); w.y = pk_bf16(a[2], a[3]); w.z = pk_bf16(a[4], a[5]); w.w = pk_bf16(a[6], a[7]);
                    *(u32x4*)(O + (size_t)r * DM + 512 + c) = w;
                }
            }
    }
};

template <class Epi> __device__ __forceinline__ void run_gemm(const Ctx& C, LAS unsigned char* lds, const bf16_t* A, const bf16_t* Bt, int M, int N, int K, const Epi& E) {
    pg8::Gemm g{A, Bt, M, N, K}; pg8::StaticOrder S; S.init(M, N, C.G, C.bid);
    pg8::gemm_phase<Epi, pg8::StaticOrder, false>(lds, g, S, E, nullptr);
    __syncthreads();
}

__device__ __forceinline__ void tr_tile(const Ctx& C, LAS float* tl, const float* __restrict__ src, int ld, int c0, int ncv, int k0, bf16_t* dst, int Kd, int r0, const float* __restrict__ gain) {
    const int tid = C.tid, cc = tid & 63, kq = tid >> 6;
#pragma unroll
    for (int i = 0; i < 8; ++i) { const int kk = kq + i * 8; float v = (cc < ncv) ? src[(size_t)(k0 + kk) * ld + c0 + cc] : 0.f; if (gain) v *= gain[k0 + kk]; tl[kk * 65 + cc] = v; }
    __syncthreads();
    const int rc = tid >> 3, kc = (tid & 7) * 8;
    float v[8];
#pragma unroll
    for (int j = 0; j < 8; ++j) v[j] = tl[(kc + j) * 65 + rc];
    u32x4 w; w.x = pk_bf16(v[0], v[1]); w.y = pk_bf16(v[2], v[3]); w.z = pk_bf16(v[4], v[5]); w.w = pk_bf16(v[6], v[7]);
    *(u32x4*)(dst + (size_t)(r0 + rc) * Kd + k0 + kc) = w;
    __syncthreads();
}
__device__ __forceinline__ void tr_job(const Ctx& C, LAS float* tl, int rot, const float* src, int ld, int c0, int ncols, int K, bf16_t* dst, int r0, const float* gain, int mode) {
    const int nct = (ncols + 63) >> 6, nkt = K >> 6, G = C.G;
    int first = (C.bid - rot) % G; if (first < 0) first += G;
    for (int t = first; t < nct * nkt; t += G) {
        const int ct = t % nct, kt = t / nct, col0 = ct * 64;
        const int rr = mode ? ((col0 >> 7) * 256 + (col0 & 127)) : col0;
        tr_tile(C, tl, src, ld, c0 + col0, min(64, ncols - col0), kt * 64, dst, K, r0 + rr, gain);
    }
}
__device__ __forceinline__ void phase_convert(const Ctx& P, int layer, LAS unsigned char* lds) {
    LAS float* tl = (LAS float*)lds;
    unsigned char* ws = P.ws; const int i = layer >> 1; const bool even = (layer & 1) == 0;
    const size_t wgu = (size_t)DM * FF;
    tr_job(P, tl, 0, inp(2) + layer * wgu, FF, 0, FF, DM, (bf16_t*)(ws + OFF_GU1), 0, inp(1) + layer * DM, 1);
    tr_job(P, tl, 0, inp(3) + layer * wgu, FF, 0, FF, DM, (bf16_t*)(ws + OFF_GU1), 128, inp(1) + layer * DM, 1);
    tr_job(P, tl, 0, inp(4) + layer * wgu, DM, 0, DM, FF, (bf16_t*)(ws + OFF_D1), 0, nullptr, 0);
    tr_job(P, tl, 0, inp(32) + layer * wgu, FF, 0, FF, DM, (bf16_t*)(ws + OFF_GU2), 0, inp(31) + layer * DM, 1);
    tr_job(P, tl, 0, inp(33) + layer * wgu, FF, 0, FF, DM, (bf16_t*)(ws + OFF_GU2), 128, inp(31) + layer * DM, 1);
    tr_job(P, tl, 0, inp(34) + layer * wgu, DM, 0, DM, FF, (bf16_t*)(ws + OFF_D2), 0, nullptr, 0);
    const float* mg = inp(5) + layer * DM;
    if (even) {
        const float* win = inp(6) + (size_t)i * DM * 2056;
        bf16_t* wt = (bf16_t*)(ws + OFF_WIN);
        tr_job(P, tl, 0, win, 2056, 0, 1536, DM, wt, 0, mg, 0);
        tr_job(P, tl, 128, win, 2056, 1544, 512, DM, wt, 1536, mg, 0);
        tr_job(P, tl, 0, win, 2056, 1536, 8, DM, wt, 2048, mg, 0);
        for (size_t e = (size_t)P.bid * 512 + P.tid; e < (size_t)192 * DM / 8; e += (size_t)P.G * 512) ((u32x4*)(wt + (size_t)2112 * DM))[e] = (u32x4){0u, 0u, 0u, 0u};
        tr_job(P, tl, 16, inp(7) + (size_t)i * DM * DM, DM, 0, DM, DM, (bf16_t*)(ws + OFF_WOUT), 0, nullptr, 0);
        tr_job(P, tl, 32, inp(22) + (size_t)i * 512 * 512, 512, 0, 512, 512, (bf16_t*)(ws + OFF_WX), 0, nullptr, 0);
    } else {
        tr_job(P, tl, 0, inp(24) + (size_t)i * DM * 2048, 2048, 0, 2048, DM, (bf16_t*)(ws + OFF_WIN), 0, mg, 0);
        tr_job(P, tl, 0, inp(25) + (size_t)i * DM * DM, DM, 0, DM, DM, (bf16_t*)(ws + OFF_WOUT), 0, nullptr, 0);
        for (int gq = 0; gq < 4; ++gq)
            tr_job(P, tl, gq * 4, inp(29) + ((size_t)i * 4 + gq) * 128 * 128, 128, 0, 128, 128, (bf16_t*)(ws + OFF_WX) + gq * 128 * 128, 0, nullptr, 0);
    }
#ifdef ZERO_SCRATCH
    if (layer == 0) { u32x4* z = (u32x4*)(ws + WS_XB); const size_t nz = (WS_END - WS_XB) / 16; for (size_t e = (size_t)P.bid * 512 + P.tid; e < nz; e += (size_t)P.G * 512) z[e] = (u32x4){0u, 0u, 0u, 0u}; asm volatile("s_waitcnt vmcnt(0)" ::: "memory"); __syncthreads(); }
#endif
    if (layer == 0) {
        const float* x = inp(0); float* xo = P.out; bf16_t* xb = (bf16_t*)(ws + WS_XB); float* ss = (float*)(ws + WS_SS);
        const int lane = P.tid & 63, wv = P.tid >> 6;
        for (int r = P.bid * 8 + wv; r < T_TOK; r += P.G * 8) {
            float q = 0.f;
#pragma unroll
            for (int k = 0; k < 4; ++k) {
                const size_t o = (size_t)r * DM + k * 256 + lane * 4;
                const f32x4 v = *(const f32x4*)(x + o); *(f32x4*)(xo + o) = v;
                u32x2 w; w.x = pk_bf16(v[0], v[1]); w.y = pk_bf16(v[2], v[3]); *(u32x2*)(xb + o) = w;
                q += (v[0] * v[0] + v[1] * v[1]) + (v[2] * v[2] + v[3] * v[3]);
            }
#pragma unroll
            for (int o = 32; o >= 1; o >>= 1) q += __shfl_xor(q, o);
            if (lane == 0) *(f32x4*)(ss + (size_t)r * 4) = (f32x4){q, 0.f, 0.f, 0.f};
        }
    }
}
__device__ __forceinline__ unsigned short bf16_1(float v) { return (unsigned short)(pk_bf16(v, 0.f) & 0xffffu); }
__device__ __forceinline__ u32x4 pack8(const float (&v)[8]) { u32x4 w; w.x = pk_bf16(v[0], v[1]); w.y = pk_bf16(v[2], v[3]); w.z = pk_bf16(v[4], v[5]); w.w = pk_bf16(v[6], v[7]); return w; }
__device__ __forceinline__ u32x2 pack4(f32x4 v) { u32x2 w; w.x = pk_bf16(v[0], v[1]); w.y = pk_bf16(v[2], v[3]); return w; }
__device__ __forceinline__ bf16x8 lfrag(const LAS unsigned char* p) { return *(const LAS bf16x8*)p; }

__device__ __forceinline__ void phase_o1(const Ctx& C, int i, LAS unsigned char* lds) {
    const int tid = C.tid, lane = tid & 63, wid = tid >> 6, fr = lane & 15, q4 = lane >> 4;
    const float* __restrict__ proj = (const float*)(C.ws + WS_R1);
    bf16_t* qn = (bf16_t*)(C.ws + WS_U2); bf16_t* kn = qn + (size_t)T_TOK * 512; bf16_t* vt = kn + (size_t)T_TOK * 512;
    bf16_t* mixed = (bf16_t*)(C.ws + WS_MIXED);
    const bf16_t* wpt = (const bf16_t*)(C.ws + OFF_WX);
    const float* qg = inp(26) + i * 64; const float* kg = inp(27) + i * 64; const float* psc = inp(30) + i * 512;
    for (int bc = C.bid; bc < 256; bc += C.G) {
        const int t0 = bc * 64, b = bc >> 6, c = bc & 63;
        {
            const int sub = tid & 15;
            const f32x4 gq = *(const f32x4*)(qg + sub * 4), gk = *(const f32x4*)(kg + sub * 4);
            for (int pass = 0; pass < 32; ++pass) {
                const int idx = pass * 32 + (tid >> 4), l = idx >> 4, rem = idx & 15, qk = rem >> 3, h = rem & 7;
                const f32x4 v = *(const f32x4*)(proj + (size_t)(t0 + l) * LDP_O + qk * 512 + h * 64 + sub * 4);
                float s = (v[0] * v[0] + v[1] * v[1]) + (v[2] * v[2] + v[3] * v[3]);
                s += __shfl_xor(s, 1); s += __shfl_xor(s, 2); s += __shfl_xor(s, 4); s += __shfl_xor(s, 8);
                const float rs = rsqrtf(s * (1.0f / 64.0f) + EPS) * (qk ? 1.0f : 0.125f);
                const f32x4 gg = qk ? gk : gq;
                *(u32x2*)((qk ? kn : qn) + (size_t)(t0 + l) * 512 + h * 64 + sub * 4) = pack4(v * rs * gg);
            }
        }
        {
            const float* pv = proj + (size_t)t0 * LDP_O + 1024 + tid;
            bf16_t* dst = vt + ((size_t)(b * 512 + tid)) * SEQ + c * 64;
            for (int l0 = 0; l0 < 8; ++l0) {
                float v[8];
#pragma unroll
                for (int j = 0; j < 8; ++j) v[j] = pv[(size_t)(l0 * 8 + j) * LDP_O];
                *(u32x4*)(dst + l0 * 8) = pack8(v);
            }
        }
        {
            const int ch = tid, gg = ch >> 7, w = 2 << gg, pos0 = c * 64;
            const float* pu = proj + (size_t)t0 * LDP_O + 1536 + ch;
            float sum = 0.f;
            if (c > 0) for (int k = 1; k <= w; ++k) sum += pu[-(long)k * LDP_O];
            for (int l = 0; l < 64; ++l) {
                const float uv = pu[(size_t)l * LDP_O]; sum += uv;
                const int pos = pos0 + l;
                if (pos - w >= 0) sum -= pu[((long)l - w) * LDP_O];
                const int cnt = min(pos + 1, w);
                ((LAS unsigned short*)lds)[l * 520 + ch] = bf16_1(sum / (float)cnt - uv);
            }
        }
        __syncthreads();
        {
            const int gg = wid >> 1, oh = wid & 1;
            f32x4 acc[4][4];
#pragma unroll
            for (int a = 0; a < 4; ++a)
#pragma unroll
                for (int d = 0; d < 4; ++d) acc[a][d] = (f32x4){0.f, 0.f, 0.f, 0.f};
#pragma unroll
            for (int ks = 0; ks < 4; ++ks) {
                bf16x8 wf[4], pf[4];
#pragma unroll
                for (int ot = 0; ot < 4; ++ot) wf[ot] = *(const bf16x8*)(wpt + ((size_t)(gg * 128 + oh * 64 + ot * 16 + fr)) * 128 + ks * 32 + q4 * 8);
#pragma unroll
                for (int lt = 0; lt < 4; ++lt) pf[lt] = lfrag(lds + ((lt * 16 + fr) * 520 + gg * 128 + ks * 32 + q4 * 8) * 2);
#pragma unroll
                for (int ot = 0; ot < 4; ++ot)
#pragma unroll
                    for (int lt = 0; lt < 4; ++lt) acc[ot][lt] = mfma16(wf[ot], pf[lt], acc[ot][lt]);
            }
#pragma unroll
            for (int ot = 0; ot < 4; ++ot) {
                const int o = oh * 64 + ot * 16 + q4 * 4;
                const f32x4 sc = *(const f32x4*)(psc + gg * 128 + o);
#pragma unroll
                for (int lt = 0; lt < 4; ++lt) *(u32x2*)(mixed + (size_t)(t0 + lt * 16 + fr) * DM + 512 + gg * 128 + o) = pack4(acc[ot][lt] * sc);
            }
        }
        __syncthreads();
    }
}

__device__ __forceinline__ void phase_o2(const Ctx& C, int i, LAS unsigned char* lds) {
    const int tid = C.tid, lane = tid & 63, wid = tid >> 6, fr = lane & 15, q4 = lane >> 4;
    LAS float* bias_s = (LAS float*)lds;
    { const float* rb = inp(28) + (size_t)i * 8 * 257; for (int e = tid; e < 8 * 257; e += 512) bias_s[e] = rb[e]; }
    __syncthreads();
    const bf16_t* __restrict__ qn = (const bf16_t*)(C.ws + WS_U2); const bf16_t* __restrict__ kn = qn + (size_t)T_TOK * 512; const bf16_t* __restrict__ vt = kn + (size_t)T_TOK * 512;
    bf16_t* mixed = (bf16_t*)(C.ws + WS_MIXED);
    const int NW = C.G * 8;
    for (int id = C.bid * 8 + wid; id < 4096; id += NW) {
        const int h = id & 7, qh = (id >> 3) & 1, bc = id >> 4, b = bc >> 6, c = bc & 63, t0 = bc * 64;
        bf16x8 qf[2][2];
#pragma unroll
        for (int qt = 0; qt < 2; ++qt)
#pragma unroll
            for (int ks = 0; ks < 2; ++ks) qf[qt][ks] = *(const bf16x8*)(qn + (size_t)(t0 + qh * 32 + qt * 16 + fr) * 512 + h * 64 + ks * 32 + q4 * 8);
        f32x4 o[4][2];
#pragma unroll
        for (int a = 0; a < 4; ++a) { o[a][0] = (f32x4){0.f, 0.f, 0.f, 0.f}; o[a][1] = (f32x4){0.f, 0.f, 0.f, 0.f}; }
        float mrun[2] = {-1e30f, -1e30f}, lsum[2] = {0.f, 0.f};
        const LAS float* bh = bias_s + h * 257;
        for (int kc = max(0, 8 - c); kc <= 8; ++kc) {
            const int kch = c - 8 + kc; const size_t s0 = (size_t)b * SEQ + kch * 64;
            f32x4 s[4][2];
#pragma unroll
            for (int kt = 0; kt < 4; ++kt) {
                const bf16_t* pk = kn + (s0 + kt * 16 + fr) * 512 + h * 64 + q4 * 8;
                const bf16x8 kf0 = *(const bf16x8*)pk, kf1 = *(const bf16x8*)(pk + 32);
#pragma unroll
                for (int qt = 0; qt < 2; ++qt) s[kt][qt] = mfma16(kf1, qf[qt][1], mfma16(kf0, qf[qt][0], (f32x4){0.f, 0.f, 0.f, 0.f}));
            }
            const int dbase = (8 - kc) * 64;
#pragma unroll
            for (int qt = 0; qt < 2; ++qt) {
                const int lq = qh * 32 + qt * 16 + fr; float mx = -1e30f;
#pragma unroll
                for (int kt = 0; kt < 4; ++kt)
#pragma unroll
                    for (int r = 0; r < 4; ++r) {
                        int dist = dbase + lq - (kt * 16 + q4 * 4 + r); dist = min(max(dist, -128), 128) + 128;
                        const float v = s[kt][qt][r] + bh[dist]; s[kt][qt][r] = v; mx = fmaxf(mx, v);
                    }
                mx = fmaxf(mx, __shfl_xor(mx, 16)); mx = fmaxf(mx, __shfl_xor(mx, 32));
                const float mnew = fmaxf(mrun[qt], mx), alpha = __expf(mrun[qt] - mnew); mrun[qt] = mnew;
                float ps = 0.f;
#pragma unroll
                for (int kt = 0; kt < 4; ++kt)
#pragma unroll
                    for (int r = 0; r < 4; ++r) { const float p = __expf(s[kt][qt][r] - mnew); s[kt][qt][r] = p; ps += p; }
                lsum[qt] = lsum[qt] * alpha + ps;
#pragma unroll
                for (int dt = 0; dt < 4; ++dt) o[dt][qt] *= alpha;
            }
#pragma unroll
            for (int kk = 0; kk < 2; ++kk) {
                bf16x8 pf[2];
#pragma unroll
                for (int qt = 0; qt < 2; ++qt) {
                    u32x4 w; w.x = pk_bf16(s[2 * kk][qt][0], s[2 * kk][qt][1]); w.y = pk_bf16(s[2 * kk][qt][2], s[2 * kk][qt][3]);
                    w.z = pk_bf16(s[2 * kk + 1][qt][0], s[2 * kk + 1][qt][1]); w.w = pk_bf16(s[2 * kk + 1][qt][2], s[2 * kk + 1][qt][3]);
                    pf[qt] = as_bf16x8(w);
                }
#pragma unroll
                for (int dt = 0; dt < 4; ++dt) {
                    const bf16_t* pv = vt + ((size_t)(b * 512 + h * 64 + dt * 16 + fr)) * SEQ + kch * 64 + kk * 32 + q4 * 4;
                    const u32x2 lo = *(const u32x2*)pv, hi = *(const u32x2*)(pv + 16);
                    const bf16x8 vf = as_bf16x8((u32x4){lo.x, lo.y, hi.x, hi.y});
#pragma unroll
                    for (int qt = 0; qt < 2; ++qt) o[dt][qt] = mfma16(vf, pf[qt], o[dt][qt]);
                }
            }
        }
#pragma unroll
        for (int qt = 0; qt < 2; ++qt) {
            float ls = lsum[qt]; ls += __shfl_xor(ls, 16); ls += __shfl_xor(ls, 32);
            const float inv = 1.0f / ls; const int lq = qh * 32 + qt * 16 + fr;
#pragma unroll
            for (int dt = 0; dt < 4; ++dt) *(u32x2*)(mixed + (size_t)(t0 + lq) * DM + h * 64 + dt * 16 + q4 * 4) = pack4(o[dt][qt] * inv);
        }
    }
    __syncthreads();
}
constexpr int L_XST = 0, L_BM = 36864, L_CM = 54272, L_BMT = 71680, L_GS = 90112, L_DTS = 126976, L_ACS = 128000;

__device__ __forceinline__ void ssd_stage(const Ctx& C, int i, LAS unsigned char* lds, int bc, int g) {
    const int tid = C.tid, lane = tid & 63, wid = tid >> 6, c = bc & 63;
    const float* __restrict__ proj = (const float*)(C.ws + WS_R1);
    const int t0 = bc * 64;
    int cx; if (tid < 256) cx = g * 256 + tid; else if (tid < 384) cx = 512 + g * 128 + (tid - 256); else cx = 768 + g * 128 + (tid - 384);
    const float* cw = inp(8) + (size_t)i * 4096; const float cb = inp(9)[i * 1024 + cx];
    const float w0 = cw[cx], w1 = cw[1024 + cx], w2 = cw[2048 + cx], w3 = cw[3072 + cx];
    const float* px = proj + (size_t)t0 * LDP_E + 512 + cx;
    float xm3 = 0.f, xm2 = 0.f, xm1 = 0.f;
    if (c > 0) { xm3 = px[-3 * LDP_E]; xm2 = px[-2 * LDP_E]; xm1 = px[-LDP_E]; }
    for (int l0 = 0; l0 < 8; ++l0) {
        float sv[8];
#pragma unroll
        for (int j = 0; j < 8; ++j) { const float xv = px[(size_t)(l0 * 8 + j) * LDP_E]; const float v = cb + w0 * xm3 + w1 * xm2 + w2 * xm1 + w3 * xv; sv[j] = silu_f(v); xm3 = xm2; xm2 = xm1; xm1 = xv; }
        const u32x4 w = pack8(sv);
        if (tid < 256) *(LAS u32x4*)(lds + L_XST + tid * 144 + l0 * 16) = w;
        else if (tid < 384) {
            const int n = tid - 256; *(LAS u32x4*)(lds + L_BMT + n * 144 + l0 * 16) = w;
            LAS unsigned short* d = (LAS unsigned short*)(lds + L_BM) + (l0 * 8) * 136 + n;
            d[0] = (unsigned short)(w.x & 0xffffu); d[136] = (unsigned short)(w.x >> 16); d[2 * 136] = (unsigned short)(w.y & 0xffffu); d[3 * 136] = (unsigned short)(w.y >> 16);
            d[4 * 136] = (unsigned short)(w.z & 0xffffu); d[5 * 136] = (unsigned short)(w.z >> 16); d[6 * 136] = (unsigned short)(w.w & 0xffffu); d[7 * 136] = (unsigned short)(w.w >> 16);
        } else {
            const int n = tid - 384;
            LAS unsigned short* d = (LAS unsigned short*)(lds + L_CM) + (l0 * 8) * 136 + n;
            d[0] = (unsigned short)(w.x & 0xffffu); d[136] = (unsigned short)(w.x >> 16); d[2 * 136] = (unsigned short)(w.y & 0xffffu); d[3 * 136] = (unsigned short)(w.y >> 16);
            d[4 * 136] = (unsigned short)(w.z & 0xffffu); d[5 * 136] = (unsigned short)(w.z >> 16); d[6 * 136] = (unsigned short)(w.w & 0xffffu); d[7 * 136] = (unsigned short)(w.w >> 16);
        }
    }
    if (wid < 4) {
        const int hh = g * 4 + wid;
        const float xx = proj[(size_t)(t0 + lane) * LDP_E + 2048 + hh] + inp(10)[i * 8 + hh];
        const float dtv = xx > 20.f ? xx : log1pf(expf(xx));
        float v = -expf(inp(11)[i * 8 + hh]) * dtv;
#pragma unroll
        for (int off = 1; off < 64; off <<= 1) { const float t = __shfl_up(v, off); if (lane >= off) v += t; }
        ((LAS float*)(lds + L_DTS))[lane * 4 + wid] = dtv; ((LAS float*)(lds + L_ACS))[lane * 4 + wid] = v;
    }
    __syncthreads();
}

__device__ __forceinline__ void ssd_states(const Ctx& C, int i, LAS unsigned char* lds) {
    const int tid = C.tid, lane = tid & 63, wid = tid >> 6, fr = lane & 15, q4 = lane >> 4;
    float* states = (float*)(C.ws + WS_U2); float* cdec = (float*)(C.ws + WS_CDEC);
    const LAS float* DTS = (const LAS float*)(lds + L_DTS); const LAS float* ACS = (const LAS float*)(lds + L_ACS);
    LAS float* WTS = (LAS float*)(lds + L_GS);
    for (int u = C.bid; u < 512; u += C.G) {
        const int g = u & 1, bc = u >> 1;
        ssd_stage(C, i, lds, bc, g);
        if (tid < 256) WTS[tid] = DTS[tid] * expf(ACS[63 * 4 + (tid & 3)] - ACS[tid]);
        if (tid < 4) cdec[bc * 8 + g * 4 + tid] = expf(ACS[63 * 4 + tid]);
        __syncthreads();
        const int j = wid >> 1, nh = wid & 1;
        f32x4 acc[4][4];
#pragma unroll
        for (int a = 0; a < 4; ++a)
#pragma unroll
            for (int d = 0; d < 4; ++d) acc[a][d] = (f32x4){0.f, 0.f, 0.f, 0.f};
#pragma unroll
        for (int ks = 0; ks < 2; ++ks) {
            float wv[8];
#pragma unroll
            for (int e = 0; e < 8; ++e) wv[e] = WTS[(ks * 32 + q4 * 8 + e) * 4 + j];
            bf16x8 af[4];
#pragma unroll
            for (int pt = 0; pt < 4; ++pt) {
                const u32x4 raw = *(const LAS u32x4*)(lds + L_XST + (j * 64 + pt * 16 + fr) * 144 + (ks * 32 + q4 * 8) * 2);
                u32x4 w; w.x = pk_bf16(bf_lo(raw.x) * wv[0], bf_hi(raw.x) * wv[1]); w.y = pk_bf16(bf_lo(raw.y) * wv[2], bf_hi(raw.y) * wv[3]);
                w.z = pk_bf16(bf_lo(raw.z) * wv[4], bf_hi(raw.z) * wv[5]); w.w = pk_bf16(bf_lo(raw.w) * wv[6], bf_hi(raw.w) * wv[7]);
                af[pt] = as_bf16x8(w);
            }
#pragma unroll
            for (int nt = 0; nt < 4; ++nt) {
                const bf16x8 bfr = lfrag(lds + L_BMT + (nh * 64 + nt * 16 + fr) * 144 + (ks * 32 + q4 * 8) * 2);
#pragma unroll
                for (int pt = 0; pt < 4; ++pt) acc[pt][nt] = mfma16(bfr, af[pt], acc[pt][nt]);
            }
        }
        float* st = states + ((size_t)(bc * 8 + g * 4 + j)) * 8192;
#pragma unroll
        for (int pt = 0; pt < 4; ++pt)
#pragma unroll
            for (int nt = 0; nt < 4; ++nt) *(f32x4*)(st + (pt * 16 + fr) * 128 + nh * 64 + nt * 16 + q4 * 4) = acc[pt][nt];
        __syncthreads();
    }
}

__device__ __forceinline__ void ssd_output(const Ctx& C, int i, LAS unsigned char* lds) {
    const int tid = C.tid, lane = tid & 63, wid = tid >> 6, fr = lane & 15, q4 = lane >> 4;
    const float* __restrict__ proj = (const float*)(C.ws + WS_R1);
    const bf16_t* __restrict__ hbf = (const bf16_t*)(C.ws + WS_HBF);
    bf16_t* mixed = (bf16_t*)(C.ws + WS_MIXED);
    const LAS float* DTS = (const LAS float*)(lds + L_DTS); const LAS float* ACS = (const LAS float*)(lds + L_ACS);
    LAS float* RED = (LAS float*)(lds + L_BMT);
    for (int u = C.bid; u < 512; u += C.G) {
        const int g = u & 1, bc = u >> 1, t0 = bc * 64;
        ssd_stage(C, i, lds, bc, g);
        {
            const int lt = wid >> 1;
            float dsk[4];
#pragma unroll
            for (int j = 0; j < 4; ++j) dsk[j] = inp(12)[i * 8 + g * 4 + j];
#pragma unroll
            for (int s2 = 0; s2 < 2; ++s2) {
                const int st = (wid & 1) * 2 + s2;
                f32x4 cb = (f32x4){0.f, 0.f, 0.f, 0.f};
#pragma unroll
                for (int ks = 0; ks < 4; ++ks)
                    cb = mfma16(lfrag(lds + L_CM + (lt * 16 + fr) * 272 + (ks * 32 + q4 * 8) * 2), lfrag(lds + L_BM + (st * 16 + fr) * 272 + (ks * 32 + q4 * 8) * 2), cb);
                const int s = st * 16 + fr;
#pragma unroll
                for (int j = 0; j < 4; ++j) {
                    const float as = ACS[s * 4 + j], dts = DTS[s * 4 + j];
#pragma unroll
                    for (int r = 0; r < 4; ++r) {
                        const int l = lt * 16 + q4 * 4 + r; float gv = 0.f;
                        if (s <= l) gv = cb[r] * __expf(ACS[l * 4 + j] - as) * dts;
                        if (s == l) gv += dsk[j];
                        ((LAS unsigned short*)(lds + L_GS))[(j * 64 + l) * 72 + s] = bf16_1(gv);
                    }
                }
            }
        }
        __syncthreads();
        const int j = wid >> 1, ph = wid & 1, hh = g * 4 + j;
        f32x4 a1[4][2], a2[4][2];
#pragma unroll
        for (int a = 0; a < 4; ++a) { a1[a][0] = (f32x4){0.f, 0.f, 0.f, 0.f}; a1[a][1] = a1[a][0]; a2[a][0] = a1[a][0]; a2[a][1] = a1[a][0]; }
#pragma unroll
        for (int ks = 0; ks < 2; ++ks) {
            bf16x8 xf[2], gf[4];
#pragma unroll
            for (int pt = 0; pt < 2; ++pt) xf[pt] = lfrag(lds + L_XST + (j * 64 + ph * 32 + pt * 16 + fr) * 144 + (ks * 32 + q4 * 8) * 2);
#pragma unroll
            for (int lt = 0; lt < 4; ++lt) gf[lt] = lfrag(lds + L_GS + (j * 64 + lt * 16 + fr) * 144 + (ks * 32 + q4 * 8) * 2);
#pragma unroll
            for (int lt = 0; lt < 4; ++lt)
#pragma unroll
                for (int pt = 0; pt < 2; ++pt) a1[lt][pt] = mfma16(xf[pt], gf[lt], a1[lt][pt]);
        }
        const bf16_t* hb = hbf + ((size_t)(bc * 8 + hh)) * 8192;
#pragma unroll
        for (int ks = 0; ks < 4; ++ks) {
            bf16x8 hf[2], cf[4];
#pragma unroll
            for (int pt = 0; pt < 2; ++pt) hf[pt] = *(const bf16x8*)(hb + (ph * 32 + pt * 16 + fr) * 128 + ks * 32 + q4 * 8);
#pragma unroll
            for (int lt = 0; lt < 4; ++lt) cf[lt] = lfrag(lds + L_CM + (lt * 16 + fr) * 272 + (ks * 32 + q4 * 8) * 2);
#pragma unroll
            for (int lt = 0; lt < 4; ++lt)
#pragma unroll
                for (int pt = 0; pt < 2; ++pt) a2[lt][pt] = mfma16(hf[pt], cf[lt], a2[lt][pt]);
        }
#pragma unroll
        for (int lt = 0; lt < 4; ++lt) {
            const int l = lt * 16 + fr; const float ea = __expf(ACS[l * 4 + j]); float q = 0.f;
#pragma unroll
            for (int pt = 0; pt < 2; ++pt) {
                const f32x4 zv = *(const f32x4*)(proj + (size_t)(t0 + l) * LDP_E + hh * 64 + ph * 32 + pt * 16 + q4 * 4);
#pragma unroll
                for (int r = 0; r < 4; ++r) { float v = a1[lt][pt][r] + ea * a2[lt][pt][r]; v *= silu_f(zv[r]); a1[lt][pt][r] = v; q += v * v; }
            }
            q += __shfl_xor(q, 16); q += __shfl_xor(q, 32);
            if (q4 == 0) RED[wid * 64 + l] = q;
        }
        __syncthreads();
#pragma unroll
        for (int lt = 0; lt < 4; ++lt) {
            const int l = lt * 16 + fr; float q = 0.f;
#pragma unroll
            for (int w = 0; w < 8; ++w) q += RED[w * 64 + l];
            const float rs = rsqrtf(q * (1.0f / 256.0f) + EPS);
#pragma unroll
            for (int pt = 0; pt < 2; ++pt) {
                const int ch = hh * 64 + ph * 32 + pt * 16 + q4 * 4;
                const f32x4 gn = *(const f32x4*)(inp(13) + i * 512 + ch);
                *(u32x2*)(mixed + (size_t)(t0 + l) * DM + ch) = pack4(a1[lt][pt] * rs * gn);
            }
        }
        __syncthreads();
    }
}

__device__ __forceinline__ void s5_disc(int i, int g, int p, float& abr, float& abi, float& fre, float& fim) {
    const float ar = inp(14)[(i * 32 + g) * 64 + p], ai = inp(15)[(i * 32 + g) * 64 + p];
    const float dt = expf(inp(16)[i * 32 + g]);
    const float em1 = expm1f(dt * ar), th = dt * ai, sn = sinf(th), cs = cosf(th), sh = sinf(0.5f * th);
    const float m1r = em1 * cs - 2.0f * sh * sh;
    abr = 1.0f + m1r; abi = (1.0f + em1) * sn;
    const float den = ar * ar + ai * ai;
    fre = (m1r * ar + abi * ai) / den; fim = (abi * ar - m1r * ai) / den;
}

__device__ __forceinline__ void s5_pass(const Ctx& C, int i, LAS unsigned char* lds, const int mode) {
    const int tid = C.tid, lane = tid & 63, wid = tid >> 6, fr = lane & 15, q4 = lane >> 4;
    const float* __restrict__ proj = (const float*)(C.ws + WS_R1);
    f32x2* s5e = (f32x2*)(C.ws + WS_S5E);
    float* ys = (float*)(C.ws + WS_U2); bf16_t* gy = (bf16_t*)(C.ws + WS_U2 + 33554432);
    LAS float* us = (LAS float*)(lds + wid * 8448);
    LAS unsigned char* hc = lds + wid * 8448 + 4096;
    const int NW = C.G * 8;
    int gprev = -1;
    float abr = 0.f, abi = 0.f, bbr[16], bbi[16]; bf16x8 cmf[4]; f32x4 dsk = (f32x4){0.f, 0.f, 0.f, 0.f};
#pragma unroll
    for (int e = 0; e < 16; ++e) { bbr[e] = 0.f; bbi[e] = 0.f; }
#pragma unroll
    for (int e = 0; e < 4; ++e) cmf[e] = as_bf16x8((u32x4){0u, 0u, 0u, 0u});
    for (int unit = C.bid * 8 + wid; unit < 8192; unit += NW) {
        const int g = unit & 31, bc = unit >> 5, t0 = bc * 64;
        if (g != gprev) {
            gprev = g;
            float fre, fim; s5_disc(i, g, lane, abr, abi, fre, fim);
            const float* pbr = inp(17) + ((size_t)(i * 32 + g) * 64 + lane) * 16; const float* pbi = inp(18) + ((size_t)(i * 32 + g) * 64 + lane) * 16;
#pragma unroll
            for (int k = 0; k < 4; ++k) {
                const f32x4 br = *(const f32x4*)(pbr + k * 4), bi = *(const f32x4*)(pbi + k * 4);
#pragma unroll
                for (int e = 0; e < 4; ++e) { bbr[k * 4 + e] = fre * br[e] - fim * bi[e]; bbi[k * 4 + e] = fre * bi[e] + fim * br[e]; }
            }
            if (mode) {
                const float* pcr = inp(19) + ((size_t)(i * 32 + g) * 16 + fr) * 64 + q4 * 8; const float* pci = inp(20) + ((size_t)(i * 32 + g) * 16 + fr) * 64 + q4 * 8;
#pragma unroll
                for (int ks = 0; ks < 2; ++ks) {
                    const f32x4 a = *(const f32x4*)(pcr + ks * 32), b2 = *(const f32x4*)(pcr + ks * 32 + 4), cc = *(const f32x4*)(pci + ks * 32), d2 = *(const f32x4*)(pci + ks * 32 + 4);
                    u32x4 w; w.x = pk_bf16(a[0], a[1]); w.y = pk_bf16(a[2], a[3]); w.z = pk_bf16(b2[0], b2[1]); w.w = pk_bf16(b2[2], b2[3]); cmf[ks] = as_bf16x8(w);
                    u32x4 v; v.x = pk_bf16(-cc[0], -cc[1]); v.y = pk_bf16(-cc[2], -cc[3]); v.z = pk_bf16(-d2[0], -d2[1]); v.w = pk_bf16(-d2[2], -d2[3]); cmf[2 + ks] = as_bf16x8(v);
                }
                dsk = *(const f32x4*)(inp(21) + (size_t)(i * 32 + g) * 16 + q4 * 4);
            }
        }
        {   const float* pu = proj + (size_t)(t0 + lane) * LDP_E + 1536 + g * 16;
#pragma unroll
            for (int k = 0; k < 4; ++k) *(LAS f32x4*)(us + lane * 16 + k * 4) = *(const f32x4*)(pu + k * 4); }
        float hr = 0.f, hi = 0.f;
        if (mode) { const f32x2 h0 = s5e[(size_t)(bc * 32 + g) * 64 + lane]; hr = h0.x; hi = h0.y; }
#pragma unroll 1
        for (int tb = 0; tb < 4; ++tb) {
#pragma unroll 4
            for (int tt = 0; tt < 16; ++tt) {
                const LAS float* ut = us + (tb * 16 + tt) * 16;
                const f32x4 u0 = *(const LAS f32x4*)ut, u1 = *(const LAS f32x4*)(ut + 4), u2 = *(const LAS f32x4*)(ut + 8), u3 = *(const LAS f32x4*)(ut + 12);
                float dr = 0.f, di = 0.f;
#pragma unroll
                for (int e = 0; e < 4; ++e) { dr += bbr[e] * u0[e]; di += bbi[e] * u0[e]; }
#pragma unroll
                for (int e = 0; e < 4; ++e) { dr += bbr[4 + e] * u1[e]; di += bbi[4 + e] * u1[e]; }
#pragma unroll
                for (int e = 0; e < 4; ++e) { dr += bbr[8 + e] * u2[e]; di += bbi[8 + e] * u2[e]; }
#pragma unroll
                for (int e = 0; e < 4; ++e) { dr += bbr[12 + e] * u3[e]; di += bbi[12 + e] * u3[e]; }
                const float nr = abr * hr - abi * hi + dr, ni = abr * hi + abi * hr + di; hr = nr; hi = ni;
                if (mode) { ((LAS unsigned short*)hc)[tt * 136 + lane] = bf16_1(hr); ((LAS unsigned short*)hc)[tt * 136 + 64 + lane] = bf16_1(hi); }
            }
            if (mode) {
                f32x4 acc = (f32x4){0.f, 0.f, 0.f, 0.f};
#pragma unroll
                for (int ks = 0; ks < 4; ++ks) acc = mfma16(cmf[ks], lfrag(hc + (fr * 136 + ks * 32 + q4 * 8) * 2), acc);
                const int t = tb * 16 + fr;
                const f32x4 uu = *(const LAS f32x4*)(us + t * 16 + q4 * 4);
                const f32x4 y = acc + dsk * uu;
                const size_t o = (size_t)(t0 + t) * 512 + g * 16 + q4 * 4;
                *(f32x4*)(ys + o) = y;
                f32x4 ge;
#pragma unroll
                for (int r = 0; r < 4; ++r) { const float z = 0.7978845608f * (y[r] + 0.044715f * y[r] * y[r] * y[r]); ge[r] = 0.5f * y[r] * (2.0f - 2.0f * __builtin_amdgcn_rcpf(1.0f + __expf(2.0f * z))); }
                *(u32x2*)(gy + o) = pack4(ge);
            }
        }
        if (!mode) s5e[(size_t)(bc * 32 + g) * 64 + lane] = (f32x2){hr, hi};
    }
}

__device__ __forceinline__ void phase_e1(const Ctx& C, int i, LAS unsigned char* lds) { ssd_states(C, i, lds); s5_pass(C, i, lds, 0); __syncthreads(); }
__device__ __forceinline__ void phase_e3(const Ctx& C, int i, LAS unsigned char* lds) { ssd_output(C, i, lds); s5_pass(C, i, lds, 1); __syncthreads(); }

__device__ __forceinline__ void phase_e2(const Ctx& C, int i) {
    const float* __restrict__ states = (const float*)(C.ws + WS_U2); const float* __restrict__ cdec = (const float*)(C.ws + WS_CDEC);
    bf16_t* __restrict__ hbf = (bf16_t*)(C.ws + WS_HBF);
    for (int idx = C.bid * 512 + C.tid; idx < 131072; idx += C.G * 512) {
        const int n2 = idx & 63, p = (idx >> 6) & 63, h = (idx >> 12) & 7, b = idx >> 15;
        f32x2 run = (f32x2){0.f, 0.f};
#pragma unroll 8
        for (int c = 0; c < 64; ++c) {
            const size_t un = (size_t)((b * 64 + c) * 8 + h), o = un * 8192 + p * 128 + n2 * 2;
            const f32x2 s = *(const f32x2*)(states + o); const float d = cdec[un];
            *(unsigned*)(hbf + o) = pk_bf16(run.x, run.y);
            run = run * d + s;
        }
    }
    f32x2* s5e = (f32x2*)(C.ws + WS_S5E);
    for (int idx = C.bid * 512 + C.tid; idx < 8192; idx += C.G * 512) {
        const int p = idx & 63, g = (idx >> 6) & 31, b = idx >> 11;
        float ar, ai, fre, fim; s5_disc(i, g, p, ar, ai, fre, fim);
#pragma unroll
        for (int k = 0; k < 6; ++k) { const float nr = ar * ar - ai * ai, ni = 2.0f * ar * ai; ar = nr; ai = ni; }
        float hr = 0.f, hi = 0.f;
        for (int c = 0; c < 64; ++c) {
            f32x2* e = s5e + (size_t)((b * 64 + c) * 32 + g) * 64 + p; const f32x2 s = *e;
            *e = (f32x2){hr, hi};
            const float nr = ar * hr - ai * hi + s.x, ni = ar * hi + ai * hr + s.y; hr = nr; hi = ni;
        }
    }
}
enum { OP_CONV = 0, OP_GU, OP_DOWN, OP_IN, OP_E1, OP_E2, OP_E3, OP_GLU, OP_O1, OP_O2, OP_OUT };
constexpr int N_PHASES = 40;

__global__ void __launch_bounds__(512, 2) fwd_kernel(Params P) {
    extern __shared__ __attribute__((aligned(16))) unsigned char lds_raw[];
    LAS unsigned char* lds = (LAS unsigned char*)lds_raw;
    cg::grid_group grid = cg::this_grid();
    unsigned char* ws = P.ws;
    float* ssb = (float*)(ws + WS_SS);
    bf16_t* xb = (bf16_t*)(ws + WS_XB);
    bf16_t* mixed = (bf16_t*)(ws + WS_MIXED);
    for (int ph = P.ph_lo; ph < P.ph_hi; ++ph) {
        Ctx C; { int t_ = threadIdx.x, b_ = blockIdx.x, g_ = gridDim.x; asm volatile("" : "+v"(t_), "+s"(b_), "+s"(g_)); unsigned char* w_ = P.ws; float* o_ = P.out; asm volatile("" : "+s"(w_), "+s"(o_)); C.out = o_; C.ws = w_; C.tid = t_; C.bid = b_; C.G = g_; }
        int layer, sub;
        if (ph < 11) { layer = 0; sub = ph; } else if (ph < 20) { layer = 1; sub = ph - 11; } else if (ph < 31) { layer = 2; sub = ph - 20; } else { layer = 3; sub = ph - 31; }
        const bool even = (layer & 1) == 0; const int i = layer >> 1;
        int op, which = 0;
        if (sub <= 3) { op = sub == 0 ? OP_CONV : sub == 1 ? OP_GU : sub == 2 ? OP_DOWN : OP_IN; }
        else if (even) { op = sub == 4 ? OP_E1 : sub == 5 ? OP_E2 : sub == 6 ? OP_E3 : sub == 7 ? OP_GLU : sub == 8 ? OP_OUT : sub == 9 ? OP_GU : OP_DOWN; which = sub >= 9; }
        else { op = sub == 4 ? OP_O1 : sub == 5 ? OP_O2 : sub == 6 ? OP_OUT : sub == 7 ? OP_GU : OP_DOWN; which = sub >= 7; }
        switch (op) {
        case OP_CONV: phase_convert(C, layer, lds); break;
        case OP_GU: {
            EpiGateUp E{(bf16_t*)(ws + WS_R1), ssb};
            run_gemm(C, lds, xb, (const bf16_t*)(ws + (which ? OFF_GU2 : OFF_GU1)), T_TOK, 2 * FF, DM, E);
        } break;
        case OP_DOWN: case OP_OUT: {
            const bool dn = (op == OP_DOWN);
            float osc = 1.0f;
#ifdef SKIP_EVEN
            if (even) osc = 0.f;
#endif
#ifdef SKIP_ODD
            if (!even) osc = 0.f;
#endif
            EpiResid E{P.out, xb, ssb, dn ? 0.5f : osc};
            const bf16_t* A = dn ? (const bf16_t*)(ws + WS_R1) : mixed;
            const bf16_t* Bt = (const bf16_t*)(ws + (dn ? (which ? OFF_D2 : OFF_D1) : OFF_WOUT));
            run_gemm(C, lds, A, Bt, T_TOK, DM, dn ? FF : DM, E);
        } break;
        case OP_IN: {
            EpiProj E{(float*)(ws + WS_R1), ssb, even ? LDP_E : LDP_O, even ? LDP_E : LDP_O};
            run_gemm(C, lds, xb, (const bf16_t*)(ws + OFF_WIN), T_TOK, even ? 2304 : 2048, DM, E);
        } break;
#ifndef SKIP_EVEN
        case OP_E1: phase_e1(C, i, lds); break;
        case OP_E2: phase_e2(C, i); break;
        case OP_E3: phase_e3(C, i, lds); break;
#endif
#ifndef SKIP_EVEN
        case OP_GLU: {
            EpiGlu E{mixed, (const float*)(ws + WS_U2), inp(23) + i * 512};
            run_gemm(C, lds, (const bf16_t*)(ws + WS_U2 + 33554432), (const bf16_t*)(ws + OFF_WX), T_TOK, 512, 512, E);
        } break;
#endif
#ifndef SKIP_ODD
        case OP_O1: phase_o1(C, i, lds); break;
        case OP_O2: phase_o2(C, i, lds); break;
#endif
        }
        if (ph + 1 < P.ph_hi) {
            asm volatile("s_waitcnt vmcnt(0) lgkmcnt(0)" ::: "memory");
            __builtin_amdgcn_fence(__ATOMIC_RELEASE, "agent");
            grid.sync();
            __builtin_amdgcn_fence(__ATOMIC_ACQUIRE, "agent");
            asm volatile("s_waitcnt vmcnt(0)" ::: "memory");
        }
    }
}

extern "C" void kernel_launch(void* const* d_in, const int* in_sizes, int n_in, void* d_out, int out_size, void* d_ws, size_t ws_size, hipStream_t stream) {
    static int grid_blocks = 0;
    if (!grid_blocks) {
        int dev = 0, cus = 0, per_cu = 0;
        hipGetDevice(&dev);
        hipDeviceGetAttribute(&cus, hipDeviceAttributeMultiprocessorCount, dev);
        hipFuncSetAttribute((const void*)fwd_kernel, hipFuncAttributeMaxDynamicSharedMemorySize, LDS_BYTES);
        hipOccupancyMaxActiveBlocksPerMultiprocessor(&per_cu, (const void*)fwd_kernel, 512, LDS_BYTES);
        if (per_cu < 1) per_cu = 1;
        grid_blocks = cus * 1;
        if (n_in != 35 || ws_size < WS_END) fprintf(stderr, "kernel_launch: unexpected n_in %d / ws_size %zu (need %zu)\n", n_in, ws_size, (size_t)WS_END);
    }
    Params p{};
    for (int k = 0; k < 35; ++k) p.in[k] = (const float*)d_in[k];
    p.out = (float*)d_out; p.ws = (unsigned char*)d_ws; p.ph_lo = 0; p.ph_hi = N_PHASES;
    void* args[] = {&p};
    hipError_t e = hipLaunchCooperativeKernel((const void*)fwd_kernel, dim3(grid_blocks), dim3(512), args, LDS_BYTES, stream);
    if (e != hipSuccess) fprintf(stderr, "cooperative launch failed: %s (grid %d)\n", hipGetErrorString(e), grid_blocks);
}
```

```cpp
#include <hip/hip_runtime.h>
#include <hip/hip_cooperative_groups.h>
#include <cstdio>
namespace cg = cooperative_groups;

#define LAS __attribute__((address_space(3)))
typedef float f32x2 __attribute__((ext_vector_type(2)));
typedef unsigned u32x2 __attribute__((ext_vector_type(2)));

namespace pg8 {
#define PG8_LAS __attribute__((address_space(3)))
typedef unsigned short bf16_t;
typedef short bf16x8 __attribute__((ext_vector_type(8)));
typedef float f32x4 __attribute__((ext_vector_type(4)));
typedef unsigned u32x4 __attribute__((ext_vector_type(4)));
constexpr int BM = 256, BK = 64, HALF = 128, HTB = HALF * BK * 2  , STAGE_BYTES = 8 * HTB, NXCD = 8, WGM = 8;

__host__ __device__ __forceinline__ int lds_byte(int r, int c) { const int st = (r >> 4) * 2 + (c >> 5), rr = r & 15, cc = c & 31, ob = rr * 64 + cc * 2; return st * 1024 + (ob ^ (((ob >> 9) & 1) << 5)); }
__host__ __device__ __forceinline__ void stage_rc(int b, int& R, int& C) { const int st = b / 1024, sb = b % 1024, swz = sb ^ (((sb >> 9) & 1) << 5); R = (st >> 1) * 16 + swz / 64; C = (st & 1) * 32 + (swz % 64) / 2; }
__host__ __device__ __forceinline__ int perm32(int rho) { const int n = rho >> 4, i = rho & 15; return 8 * (i >> 2) + 4 * n + (i & 3); }

struct Unit { int pm, pn; };
struct Gemm { const bf16_t* A; const bf16_t* Bt; int M, N, K; };

struct StaticOrder {
    int nM, nN, nwg, G, c;
    __host__ __device__ void init(int M, int N, int G_, int c_) { nM = M / BM; nN = N / BM; nwg = nM * nN; G = G_; c = c_; }
    __host__ __device__ bool next(int i, Unit& u) const {
        const long L = (long)i * G + c; if (L >= nwg) return false;
        int wgid = (int)L; { const int q = nwg / NXCD, r = nwg % NXCD, xcd = wgid % NXCD, off = wgid / NXCD; wgid = (xcd < r ? xcd * (q + 1) : r * (q + 1) + (xcd - r) * q) + off; }
        const int nig = WGM * nN, gid = wgid / nig, fm = gid * WGM, gsz = (nM - fm) < WGM ? (nM - fm) : WGM;
        u.pm = fm + ((wgid % nig) % gsz); u.pn = (wgid % nig) / gsz; return true;
    }
    __device__ __forceinline__ void a_ready(const Unit&) const {}
    __device__ __forceinline__ void done(const Unit&) const {}
};
template <class Epi, class Sched, bool STAMP = false>
__device__ __forceinline__ void gemm_phase(PG8_LAS unsigned char* lds, const Gemm g, const Sched& S, const Epi& E, unsigned long long* stamps) {
    int tid_l = threadIdx.x; asm volatile("" : "+v"(tid_l));
    const int tid = tid_l, wid = __builtin_amdgcn_readfirstlane(tid >> 6), lane = tid & 63, wr = wid >> 2, wc = wid & 3, fr = lane & 15, fq = lane >> 4;
    const int K = g.K, nt = K / BK;
    int ts_lo = 0, ts_hi = 0, nts = 0; const unsigned long long rt_entry = STAMP ? (unsigned long long)wall_clock64() : 0ull;
#define PG8_STAMP() do { if (STAMP && wid == 0 && nts < 64) { const unsigned long long _c = (unsigned long long)clock64(); \
        ts_lo = (lane == nts) ? (int)(unsigned)_c : ts_lo; ts_hi = (lane == nts) ? (int)(unsigned)(_c >> 32) : ts_hi; ++nts; } } while (0)
    PG8_STAMP();
    unsigned voffA[2], voffB[2];
#pragma unroll
    for (int i = 0; i < 2; ++i) { int R, C; stage_rc(tid * 16 + i * 8192, R, C); const int Rb = Epi::PERM ? ((R & ~31) + perm32(R & 31)) : R;
        voffA[i] = (unsigned)(R * K + C) * 2u; voffB[i] = (unsigned)(Rb * K + C) * 2u; }
    const size_t kstep = (size_t)(BK * 2);
    const size_t hstep = (size_t)HALF * K * 2;
    const size_t tstep = 2 * hstep;
    const unsigned ldsw = (unsigned)wid * 1024u;
    const int aoff = lds_byte(wr * 64 + fr, fq * 8), boff = lds_byte(wc * 32 + fr, fq * 8);
#define PG8_SA(b, h) (((b) * 2 + (h)) * HTB)
#define PG8_SB(b, h) ((4 + (b) * 2 + (h)) * HTB)
#define PG8_STAGE(bufoff, gbase, voff) do { _Pragma("unroll") for (int _i = 0; _i < 2; ++_i) \
        __builtin_amdgcn_global_load_lds((const unsigned*)((const char*)(gbase) + (voff)[_i]), (PG8_LAS unsigned*)(lds + (bufoff) + ldsw + _i * 8192), 16, 0, 0); } while (0)
#define PG8_LDA(dst, b, h) do { _Pragma("unroll") for (int m = 0; m < 4; ++m) _Pragma("unroll") for (int k = 0; k < 2; ++k) dst[m][k] = *(const PG8_LAS bf16x8*)(lds + PG8_SA(b, h) + aoff + m * 2048 + k * 1024); } while (0)
#define PG8_LDB(dst, b, h) do { _Pragma("unroll") for (int n = 0; n < 2; ++n) _Pragma("unroll") for (int k = 0; k < 2; ++k) dst[n][k] = *(const PG8_LAS bf16x8*)(lds + PG8_SB(b, h) + boff + n * 2048 + k * 1024); } while (0)
#define PG8_MMA(ai, bj, At, Bt) do { __builtin_amdgcn_s_setprio(1); _Pragma("unroll") for (int m = 0; m < 4; ++m) _Pragma("unroll") for (int n = 0; n < 2; ++n) _Pragma("unroll") for (int k = 0; k < 2; ++k) \
        acc[ai][bj][m][n] = __builtin_amdgcn_mfma_f32_16x16x32_bf16(Bt[n][k], At[m][k], acc[ai][bj][m][n], 0, 0, 0); __builtin_amdgcn_s_setprio(0); } while (0)
#define PG8_WAIT_V(n) asm volatile("s_waitcnt vmcnt(" #n ")" ::: "memory")
#define PG8_WAIT_L(n) asm volatile("s_waitcnt lgkmcnt(" #n ")" ::: "memory")
#define PG8_BAR __builtin_amdgcn_s_barrier()
#define PG8_SCHED __builtin_amdgcn_sched_barrier(0)
    Unit cur, nxt; int ui = 0;
    if (!S.next(0, cur)) return;
    f32x4 acc[2][2][4][2];
#pragma unroll
    for (int a = 0; a < 2; ++a)
#pragma unroll
        for (int b = 0; b < 2; ++b)
#pragma unroll
            for (int m = 0; m < 4; ++m)
#pragma unroll
                for (int n = 0; n < 2; ++n) acc[a][b][m][n] = (f32x4){0.f, 0.f, 0.f, 0.f};
    bf16x8 At[4][2], B0[2][2], B1[2][2];
    const char* cA = (const char*)g.A + (size_t)cur.pm * tstep; const char* cB = (const char*)g.Bt + (size_t)cur.pn * tstep;
    S.a_ready(cur);
    PG8_STAGE(PG8_SB(0, 0), cB, voffB); PG8_STAGE(PG8_SA(0, 0), cA, voffA); PG8_STAGE(PG8_SB(0, 1), cB + hstep, voffB); PG8_STAGE(PG8_SA(0, 1), cA + hstep, voffA);
    if (wr == 1) PG8_BAR;
    PG8_WAIT_V(4); PG8_BAR;
    PG8_STAGE(PG8_SB(1, 0), cB + kstep, voffB); PG8_STAGE(PG8_SA(1, 0), cA + kstep, voffA); PG8_STAGE(PG8_SB(1, 1), cB + hstep + kstep, voffB);
    PG8_WAIT_V(6); PG8_BAR;
    PG8_STAMP();
    for (;;) {
        const bool has_next = S.next(ui + 1, nxt);
        const char* nA = has_next ? (const char*)g.A + (size_t)nxt.pm * tstep : cA; const char* nB = has_next ? (const char*)g.Bt + (size_t)nxt.pn * tstep : cB;
        for (int t = 0; t < nt; t += 2) {
            const bool last = (t == nt - 2);
            const char* a1 = cA + (size_t)(t + 1) * kstep;
            const char* a2 = last ? nA : cA + (size_t)(t + 2) * kstep; const char* b2 = last ? nB : cB + (size_t)(t + 2) * kstep;
            const char* a3 = a2 + kstep; const char* b3 = b2 + kstep;
            if (last && has_next) S.a_ready(nxt);
            PG8_LDB(B0, 0, 0); PG8_SCHED; PG8_LDA(At, 0, 0); PG8_STAGE(PG8_SA(1, 1), a1 + hstep, voffA);
            PG8_WAIT_L(8); PG8_BAR; PG8_WAIT_L(0); PG8_MMA(0, 0, At, B0); PG8_BAR; PG8_SCHED;
            PG8_LDB(B1, 0, 1); PG8_STAGE(PG8_SB(0, 0), b2, voffB);
            PG8_BAR; PG8_WAIT_L(0); PG8_MMA(0, 1, At, B1); PG8_BAR;
            PG8_LDA(At, 0, 1); PG8_STAGE(PG8_SA(0, 0), a2, voffA);
            PG8_BAR; PG8_WAIT_L(0); PG8_MMA(1, 0, At, B0); PG8_BAR; PG8_SCHED;
            PG8_STAGE(PG8_SB(0, 1), b2 + hstep, voffB);
            PG8_WAIT_V(6); PG8_BAR; PG8_MMA(1, 1, At, B1); PG8_BAR;
            PG8_LDB(B0, 1, 0); PG8_SCHED; PG8_LDA(At, 1, 0); PG8_STAGE(PG8_SA(0, 1), a2 + hstep, voffA);
            PG8_WAIT_L(8); PG8_BAR; PG8_WAIT_L(0); PG8_MMA(0, 0, At, B0); PG8_BAR; PG8_SCHED;
            PG8_LDB(B1, 1, 1); PG8_STAGE(PG8_SB(1, 0), b3, voffB);
            PG8_BAR; PG8_WAIT_L(0); PG8_MMA(0, 1, At, B1); PG8_BAR;
            PG8_LDA(At, 1, 1); PG8_STAGE(PG8_SA(1, 0), a3, voffA);
            PG8_BAR; PG8_WAIT_L(0); PG8_MMA(1, 0, At, B0); PG8_BAR; PG8_SCHED;
            PG8_STAGE(PG8_SB(1, 1), b3 + hstep, voffB);
            PG8_WAIT_V(6); PG8_BAR; PG8_MMA(1, 1, At, B1); PG8_BAR;
        }
        PG8_STAMP();
        if constexpr (!Epi::AFTER_DRAIN) { E(acc, cur, wr, wc, fr, fq); S.done(cur); }
        PG8_STAMP();
        if (!has_next) break;
#pragma unroll
        for (int a = 0; a < 2; ++a)
#pragma unroll
            for (int b = 0; b < 2; ++b)
#pragma unroll
                for (int m = 0; m < 4; ++m)
#pragma unroll
                    for (int n = 0; n < 2; ++n) acc[a][b][m][n] = (f32x4){0.f, 0.f, 0.f, 0.f};
        cur = nxt; cA = nA; cB = nB; ++ui;
    }
    PG8_WAIT_V(0);
    if (wr == 0) PG8_BAR;
    PG8_BAR;
    if constexpr (Epi::AFTER_DRAIN) { E.fused(acc, cur, wr, wc, fr, fq, lds, wid, lane); S.done(cur); }
    PG8_STAMP();
    if (STAMP && wid == 0) { stamps[lane] = lane < nts ? (((unsigned long long)(unsigned)ts_hi << 32) | (unsigned)ts_lo) : 0ull;
        if (lane == 62) stamps[62] = rt_entry; if (lane == 63) stamps[63] = (unsigned long long)wall_clock64(); }
#undef PG8_STAMP
#undef PG8_SA
#undef PG8_SB
#undef PG8_STAGE
#undef PG8_LDA
#undef PG8_LDB
#undef PG8_MMA
#undef PG8_WAIT_V
#undef PG8_WAIT_L
#undef PG8_BAR
#undef PG8_SCHED
}
}
using pg8::bf16_t; using pg8::bf16x8; using pg8::f32x4; using pg8::u32x4;

constexpr int T_TOK = 16384, DM = 1024, FF = 2816, SEQ = 4096, NCH = 64;
constexpr float EPS = 1e-6f;
constexpr int LDP_E = 2056, LDP_O = 2048;
constexpr size_t OFF_GU1 = 0, OFF_D1 = 11534336, OFF_GU2 = 17301504, OFF_D2 = 28835840, OFF_WIN = 34603008, OFF_WOUT = 39321600, OFF_WX = 41418752;
constexpr size_t WS_XB = 41943040, WS_R1 = 75497472, WS_MIXED = 210239488, WS_U2 = 243793920, WS_HBF = 310902784, WS_S5E = 344457216, WS_SS = 348651520, WS_CDEC = 349503488, WS_BAR = 349511680, WS_DTR = 349511680 + 16384, WS_END = 349511680 + 16384 + 524288;
constexpr int LDS_RS = 131072 + 16, LDS_BYTES = LDS_RS + 8 * 256 * 4;

struct Params { const float* in[35]; float* out; unsigned char* ws; int ph_lo, ph_hi; };
typedef const float* cfp_t;
__device__ __forceinline__ const float* inp(int k) { asm volatile("" : "+s"(k)); return ((const __attribute__((address_space(4))) cfp_t*)__builtin_amdgcn_kernarg_segment_ptr())[k]; }
struct Ctx { float* out; unsigned char* ws; int tid, bid, G, wk, nw, vb; };

__device__ __forceinline__ unsigned pk_bf16(float lo, float hi) { unsigned r; asm("v_cvt_pk_bf16_f32 %0, %1, %2" : "=v"(r) : "v"(lo), "v"(hi)); return r; }
__device__ __forceinline__ float bfv(unsigned short v) { return __uint_as_float((unsigned)v << 16); }
__device__ __forceinline__ float bf_lo(unsigned w) { return __uint_as_float(w << 16); }
__device__ __forceinline__ float bf_hi(unsigned w) { return __uint_as_float(w & 0xffff0000u); }
__device__ __forceinline__ float silu_f(float v) { return v * __builtin_amdgcn_rcpf(1.0f + __expf(-v)); }
__device__ __forceinline__ f32x4 mfma16(bf16x8 a, bf16x8 b, f32x4 c) { return __builtin_amdgcn_mfma_f32_16x16x32_bf16(a, b, c, 0, 0, 0); }
__device__ __forceinline__ bf16x8 as_bf16x8(u32x4 w) { return __builtin_bit_cast(bf16x8, w); }
__device__ __forceinline__ u32x4 as_u32x4(bf16x8 w) { return __builtin_bit_cast(u32x4, w); }

struct EpiGateUp {
    static constexpr bool PERM = true, AFTER_DRAIN = false;
    static constexpr bool NEED_RS = true;
    bf16_t* O; const float* ss; const LAS float* rst; mutable int k;
    __device__ __forceinline__ void operator()(const f32x4 (&acc)[2][2][4][2], const pg8::Unit& u, int wr, int wc, int fr, int fq) const {
        const int slot = k++;
        const int row0 = u.pm * 256 + wr * 64 + fr, col0 = u.pn * 128 + wc * 32 + 8 * fq;
#pragma unroll
        for (int ai = 0; ai < 2; ++ai)
#pragma unroll
            for (int m = 0; m < 4; ++m) {
                const int r = row0 + ai * 128 + m * 16;
                float rs;
                if (slot < 8) rs = rst[slot * 256 + (r & 255)];
                else { const f32x4 sp = *(const f32x4*)(ss + (size_t)r * 4); rs = rsqrtf(((sp[0] + sp[1]) + (sp[2] + sp[3])) * (1.0f / 1024.0f) + EPS); }
                float a[8];
                const float k1 = -1.44269504f * rs, rs2 = rs * rs;
#pragma unroll
                for (int n = 0; n < 2; ++n)
#pragma unroll
                    for (int h = 0; h < 2; ++h) {
                        const f32x2 ag = (f32x2){acc[ai][0][m][n][2 * h], acc[ai][0][m][n][2 * h + 1]}, au = (f32x2){acc[ai][1][m][n][2 * h], acc[ai][1][m][n][2 * h + 1]};
                        const f32x2 t = ag * k1; f32x2 e; e.x = __builtin_amdgcn_exp2f(t.x); e.y = __builtin_amdgcn_exp2f(t.y);
                        const f32x2 d = e + 1.0f; f32x2 r; r.x = __builtin_amdgcn_rcpf(d.x); r.y = __builtin_amdgcn_rcpf(d.y);
                        const f32x2 o = (ag * au) * (r * rs2);
                        a[n * 4 + 2 * h] = o.x; a[n * 4 + 2 * h + 1] = o.y;
                    }
                u32x4 w; w.x = pk_bf16(a[0], a[1]); w.y = pk_bf16(a[2], a[3]); w.z = pk_bf16(a[4], a[5]); w.w = pk_bf16(a[6], a[7]);
                *(u32x4*)(O + (size_t)r * FF + col0) = w;
            }
    }
};
struct EpiResid {
    static constexpr bool PERM = true, AFTER_DRAIN = true;
    static constexpr bool NEED_RS = false;
    float* xout; bf16_t* xb; float* ssn; float scale;
    __device__ __forceinline__ void fused(f32x4 (&acc)[2][2][4][2], const pg8::Unit& u, int wr, int wc, int fr, int fq, LAS unsigned char* lds, int wid, int lane) const {
        const int row0 = u.pm * 256 + wr * 64 + fr, col0 = u.pn * 256 + wc * 32 + 8 * fq;
        LAS float* Pq = (LAS float*)lds;
#pragma unroll
        for (int ai = 0; ai < 2; ++ai)
#pragma unroll
            for (int m = 0; m < 4; ++m) {
                const int r = row0 + ai * 128 + m * 16; float q = 0.f;
#pragma unroll
                for (int bj = 0; bj < 2; ++bj) {
                    const size_t o = (size_t)r * DM + col0 + bj * 128;
                    const u32x4 xo = *(const u32x4*)(xb + o);
                    f32x4 v0 = (f32x4){bf_lo(xo.x), bf_hi(xo.x), bf_lo(xo.y), bf_hi(xo.y)}, v1 = (f32x4){bf_lo(xo.z), bf_hi(xo.z), bf_lo(xo.w), bf_hi(xo.w)};
                    v0 += acc[ai][bj][m][0] * scale; v1 += acc[ai][bj][m][1] * scale;
                    if (xout) { *(f32x4*)(xout + o) = v0; *(f32x4*)(xout + o + 4) = v1; }
                    u32x4 w; w.x = pk_bf16(v0[0], v0[1]); w.y = pk_bf16(v0[2], v0[3]); w.z = pk_bf16(v1[0], v1[1]); w.w = pk_bf16(v1[2], v1[3]);
                    *(u32x4*)(xb + o) = w;
                    const float r0 = bf_lo(w.x), r1 = bf_hi(w.x), r2 = bf_lo(w.y), r3 = bf_hi(w.y), r4 = bf_lo(w.z), r5 = bf_hi(w.z), r6 = bf_lo(w.w), r7 = bf_hi(w.w);
                    q += ((r0 * r0 + r1 * r1) + (r2 * r2 + r3 * r3)) + ((r4 * r4 + r5 * r5) + (r6 * r6 + r7 * r7));
                }
                q += __shfl_xor(q, 16); q += __shfl_xor(q, 32);
                if (fq == 0) Pq[(ai * 128 + wr * 64 + m * 16 + fr) * 4 + wc] = q;
            }
        asm volatile("s_waitcnt lgkmcnt(0)" ::: "memory"); __builtin_amdgcn_s_barrier(); asm volatile("" ::: "memory");
        const int t = wid * 64 + lane;
        if (t < 256) { const f32x4 p = *(const LAS f32x4*)(Pq + t * 4); ssn[(size_t)(u.pm * 256 + t) * 4 + u.pn] = (p[0] + p[1]) + (p[2] + p[3]); }
    }
};
struct EpiProj {
    static constexpr bool PERM = true, AFTER_DRAIN = false;
    static constexpr bool NEED_RS = true;
    bf16_t* O; const float* ss; float* dtr; int ld, ncv; const LAS float* rst; mutable int k;
    __device__ __forceinline__ void operator()(const f32x4 (&acc)[2][2][4][2], const pg8::Unit& u, int wr, int wc, int fr, int fq) const {
        const int slot = k++;
        const int row0 = u.pm * 256 + wr * 64 + fr, col0 = u.pn * 256 + wc * 32 + 8 * fq;
#pragma unroll
        for (int ai = 0; ai < 2; ++ai)
#pragma unroll
            for (int m = 0; m < 4; ++m) {
                const int r = row0 + ai * 128 + m * 16;
                float rs;
                if (slot < 8) rs = rst[slot * 256 + (r & 255)];
                else { const f32x4 sp = *(const f32x4*)(ss + (size_t)r * 4); rs = rsqrtf(((sp[0] + sp[1]) + (sp[2] + sp[3])) * (1.0f / 1024.0f) + EPS); }
#pragma unroll
                for (int bj = 0; bj < 2; ++bj) {
                    const int c = col0 + bj * 128;
                    if (c < ncv) {
                        const f32x4 v0 = acc[ai][bj][m][0] * rs, v1 = acc[ai][bj][m][1] * rs;
                        u32x4 w; w.x = pk_bf16(v0[0], v0[1]); w.y = pk_bf16(v0[2], v0[3]); w.z = pk_bf16(v1[0], v1[1]); w.w = pk_bf16(v1[2], v1[3]);
                        *(u32x4*)(O + (size_t)r * ld + c) = w;
                        if (dtr && c == 2048) { *(f32x4*)(dtr + (size_t)r * 8) = v0; *(f32x4*)(dtr + (size_t)r * 8 + 4) = v1; }
                    }
                }
            }
    }
};
struct EpiGlu {
    static constexpr bool PERM = true, AFTER_DRAIN = false;
    static constexpr bool NEED_RS = false;
    bf16_t* O; const float* ys; const float* bias;
    __device__ __forceinline__ void operator()(const f32x4 (&acc)[2][2][4][2], const pg8::Unit& u, int wr, int wc, int fr, int fq) const {
        const int row0 = u.pm * 256 + wr * 64 + fr, col0 = u.pn * 256 + wc * 32 + 8 * fq;
#pragma unroll
        for (int ai = 0; ai < 2; ++ai)
#pragma unroll
            for (int m = 0; m < 4; ++m) {
                const int r = row0 + ai * 128 + m * 16;
#pragma unroll
                for (int bj = 0; bj < 2; ++bj) {
                    const int c = col0 + bj * 128; float a[8];
#pragma unroll
                    for (int n = 0; n < 2; ++n) {
                        const f32x4 bv = *(const f32x4*)(bias + c + 4 * n), yv = *(const f32x4*)(ys + (size_t)r * 512 + c + 4 * n);
#pragma unroll
                        for (int j = 0; j < 4; ++j) { const float gt = acc[ai][bj][m][n][j] + bv[j]; a[n * 4 + j] = yv[j] * __builtin_amdgcn_rcpf(1.0f + __expf(-gt)); }
                    }
                    u32x4 w; w.x = pk_bf16(a[0], a[1]); w.y = pk_bf16(a[2], a[3]); w.z = pk_bf16(a[4], a[5]); w.w = pk_bf16(a[6], a[7]);
                    *(u32x4*)(O + (size_t)r * DM + 512 + c) = w;
                }
            }
    }
};

template <class Epi> __device__ __forceinline__ void run_gemm(const Ctx& C, LAS unsigned char* lds, const bf16_t* A, const bf16_t* Bt, int M, int N, int K, const Epi& E) {
    pg8::Gemm g{A, Bt, M, N, K}; pg8::StaticOrder S; S.init(M, N, C.G, C.bid);
    if constexpr (Epi::NEED_RS) {
        LAS float* rst = (LAS float*)(lds + LDS_RS);
#pragma unroll 1
        for (int i = 0; i < 8; ++i) {
            pg8::Unit u; if (!S.next(i, u)) break;
            if (C.tid < 256) { const f32x4 sp = *(const f32x4*)(E.ss + (size_t)(u.pm * 256 + C.tid) * 4); rst[i * 256 + C.tid] = rsqrtf(((sp[0] + sp[1]) + (sp[2] + sp[3])) * (1.0f / 1024.0f) + EPS); }
        }
        __syncthreads();
    }
    pg8::gemm_phase<Epi, pg8::StaticOrder, false>(lds, g, S, E, nullptr);
    __syncthreads();
}

__device__ __forceinline__ void tr_tile(const Ctx& C, LAS float* tl, const float* __restrict__ src, int ld, int c0, int col0, int ncols, int k0, bf16_t* dst, int Kd, int r0, const float* __restrict__ gain, int mode) {
    const int tid = C.tid, cc = tid & 255, kq = tid >> 8;
    const bool ok = (col0 + cc) < ncols;
    const float* ps = src + (size_t)(k0 + kq) * ld + c0 + col0 + cc;
    float v[32];
#pragma unroll
    for (int i = 0; i < 32; ++i) v[i] = ok ? ps[(size_t)(2 * i) * ld] : 0.f;
    if (gain) {
#pragma unroll
        for (int i = 0; i < 32; ++i) v[i] *= gain[k0 + kq + 2 * i];
    }
#pragma unroll
    for (int i = 0; i < 32; ++i) tl[(kq + 2 * i) * 257 + cc] = v[i];
    __syncthreads();
    const int kc = (tid & 7) * 8;
#pragma unroll
    for (int pass = 0; pass < 4; ++pass) {
        const int rc = (tid >> 3) + pass * 64, col = col0 + rc;
        float o[8];
#pragma unroll
        for (int j = 0; j < 8; ++j) o[j] = tl[(kc + j) * 257 + rc];
        u32x4 w; w.x = pk_bf16(o[0], o[1]); w.y = pk_bf16(o[2], o[3]); w.z = pk_bf16(o[4], o[5]); w.w = pk_bf16(o[6], o[7]);
        const int row = r0 + (mode ? ((col >> 7) * 256 + (col & 127)) : col);
        if (col < ((ncols + 63) & ~63)) *(u32x4*)(dst + (size_t)row * Kd + k0 + kc) = w;
    }
    __syncthreads();
}
__device__ __forceinline__ void tr_job(const Ctx& C, LAS float* tl, int rot, const float* src, int ld, int c0, int ncols, int K, bf16_t* dst, int r0, const float* gain, int mode) {
    const int nct = (ncols + 255) >> 8, nkt = K >> 6, G = C.nw;
    int first = (C.wk - rot) % G; if (first < 0) first += G;
    for (int t = first; t < nct * nkt; t += G) {
        const int ct = t % nct, kt = t / nct;
        tr_tile(C, tl, src, ld, c0, ct * 256, ncols, kt * 64, dst, K, r0, gain, mode);
    }
}
__device__ __forceinline__ void phase_convert(const Ctx& P, int layer, LAS unsigned char* lds, int parts) {
    LAS float* tl = (LAS float*)lds;
    unsigned char* ws = P.ws; const int i = layer >> 1; const bool even = (layer & 1) == 0;
    const size_t wgu = (size_t)DM * FF;
    if (parts & 1) {
        tr_job(P, tl, 0, inp(2) + layer * wgu, FF, 0, FF, DM, (bf16_t*)(ws + OFF_GU1), 0, inp(1) + layer * DM, 1);
        tr_job(P, tl, 0, inp(3) + layer * wgu, FF, 0, FF, DM, (bf16_t*)(ws + OFF_GU1), 128, inp(1) + layer * DM, 1);
        tr_job(P, tl, 0, inp(4) + layer * wgu, DM, 0, DM, FF, (bf16_t*)(ws + OFF_D1), 0, nullptr, 0);
    }
    if (parts & 2) {
        tr_job(P, tl, 0, inp(32) + layer * wgu, FF, 0, FF, DM, (bf16_t*)(ws + OFF_GU2), 0, inp(31) + layer * DM, 1);
        tr_job(P, tl, 48, inp(33) + layer * wgu, FF, 0, FF, DM, (bf16_t*)(ws + OFF_GU2), 128, inp(31) + layer * DM, 1);
    }
    if (parts & 4) {
        tr_job(P, tl, 0, inp(34) + layer * wgu, DM, 0, DM, FF, (bf16_t*)(ws + OFF_D2), 0, nullptr, 0);
    }
    const float* mg = inp(5) + layer * DM;
    if (!(parts & 8)) {}
    else if (even) {
        const float* win = inp(6) + (size_t)i * DM * 2056;
        bf16_t* wt = (bf16_t*)(ws + OFF_WIN);
        tr_job(P, tl, 0, win, 2056, 0, 1536, DM, wt, 0, mg, 0);
        tr_job(P, tl, 128, win, 2056, 1544, 512, DM, wt, 1536, mg, 0);
        tr_job(P, tl, 0, win, 2056, 1536, 8, DM, wt, 2048, mg, 0);
        for (size_t e = (size_t)P.wk * 512 + P.tid; e < (size_t)192 * DM / 8; e += (size_t)P.nw * 512) ((u32x4*)(wt + (size_t)2112 * DM))[e] = (u32x4){0u, 0u, 0u, 0u};
        tr_job(P, tl, 16, inp(7) + (size_t)i * DM * DM, DM, 0, DM, DM, (bf16_t*)(ws + OFF_WOUT), 0, nullptr, 0);
        tr_job(P, tl, 32, inp(22) + (size_t)i * 512 * 512, 512, 0, 512, 512, (bf16_t*)(ws + OFF_WX), 0, nullptr, 0);
    } else {
        tr_job(P, tl, 0, inp(24) + (size_t)i * DM * 2048, 2048, 0, 2048, DM, (bf16_t*)(ws + OFF_WIN), 0, mg, 0);
        tr_job(P, tl, 0, inp(25) + (size_t)i * DM * DM, DM, 0, DM, DM, (bf16_t*)(ws + OFF_WOUT), 0, nullptr, 0);
        for (int gq = 0; gq < 4; ++gq)
            tr_job(P, tl, gq * 4, inp(29) + ((size_t)i * 4 + gq) * 128 * 128, 128, 0, 128, 128, (bf16_t*)(ws + OFF_WX) + gq * 128 * 128, 0, nullptr, 0);
    }
#ifdef ZERO_SCRATCH
    if (layer == 0) { u32x4* z = (u32x4*)(ws + WS_XB); const size_t nz = (WS_END - WS_XB) / 16; for (size_t e = (size_t)P.bid * 512 + P.tid; e < nz; e += (size_t)P.G * 512) z[e] = (u32x4){0u, 0u, 0u, 0u}; asm volatile("s_waitcnt vmcnt(0)" ::: "memory"); __syncthreads(); }
#endif
    if (layer == 0 && (parts & 16)) {
        const float* x = inp(0); bf16_t* xb = (bf16_t*)(ws + WS_XB); float* ss = (float*)(ws + WS_SS);
        const int lane = P.tid & 63, wv = P.tid >> 6;
        for (int r = P.bid * 8 + wv; r < T_TOK; r += P.G * 8) {
            float q = 0.f;
#pragma unroll
            for (int k = 0; k < 4; ++k) {
                const size_t o = (size_t)r * DM + k * 256 + lane * 4;
                const f32x4 v = *(const f32x4*)(x + o);
                u32x2 w; w.x = pk_bf16(v[0], v[1]); w.y = pk_bf16(v[2], v[3]); *(u32x2*)(xb + o) = w;
                const float r0 = bf_lo(w.x), r1 = bf_hi(w.x), r2 = bf_lo(w.y), r3 = bf_hi(w.y);
                q += (r0 * r0 + r1 * r1) + (r2 * r2 + r3 * r3);
            }
#pragma unroll
            for (int o = 32; o >= 1; o >>= 1) q += __shfl_xor(q, o);
            if (lane == 0) *(f32x4*)(ss + (size_t)r * 4) = (f32x4){q, 0.f, 0.f, 0.f};
        }
    }
}

#define XB_TMO      128
#define XB_XCNT(j)  (256  + 64 * (j))
#define XB_XSUB(j)  (1280 + 64 * (j))
#define XB_XGEN(j)  (2304 + 64 * (j))
#define XB_TOP      3328
#define XB_TOPGEN   3392
#define XCD_BAR_WORDS 3456
#define XB_SPIN_CAP (1u << 18)

__device__ __forceinline__ unsigned xb_ld(unsigned* p)              { return __hip_atomic_load(p, __ATOMIC_RELAXED, __HIP_MEMORY_SCOPE_AGENT); }
__device__ __forceinline__ unsigned xb_add(unsigned* p, unsigned v) { return __hip_atomic_fetch_add(p, v, __ATOMIC_RELAXED, __HIP_MEMORY_SCOPE_AGENT); }
__device__ __forceinline__ unsigned xb_xcc_id() { return (unsigned)__builtin_amdgcn_s_getreg((3 << 11) | 20) & 0xFu; }
#define XB_SPIN(cond, bar) do { unsigned _sp = 0; while (cond) { __builtin_amdgcn_s_sleep(1); \
    if ((++_sp & 255u) == 0u) { if (xb_ld(&(bar)[XB_TMO])) break; if (_sp > XB_SPIN_CAP) { atomicAdd(&(bar)[XB_TMO], 1u); break; } } } } while (0)

struct XcdBarrier {
    unsigned* bar; unsigned x;
    volatile LAS unsigned* st;
};

__device__ __forceinline__ XcdBarrier xcd_barrier_post(unsigned* bar, volatile LAS unsigned* st) {
    XcdBarrier b; b.bar = bar; b.x = xb_xcc_id(); b.st = st;
    if (threadIdx.x == 0) (void)xb_add(&bar[XB_XCNT(b.x)], 1u);
    return b;
}
__device__ __forceinline__ void xcd_barrier_complete(unsigned* bar, unsigned x, unsigned& nloc, unsigned& nx) {
    const unsigned G = gridDim.x * gridDim.y * gridDim.z;
    unsigned sum, cnt, mine, sp = 0u;
    for (;;) {
        sum = 0u; cnt = 0u; mine = 0u;
#pragma unroll
        for (unsigned j = 0; j < 16; ++j) { const unsigned c = xb_ld(&bar[XB_XCNT(j)]); sum += c; cnt += (c > 0u) ? 1u : 0u; mine = (j == x) ? c : mine; }
        if (sum == G) break;
        __builtin_amdgcn_s_sleep(1);
        if ((++sp & 255u) == 0u) { if (xb_ld(&bar[XB_TMO])) break; if (sp > XB_SPIN_CAP) { atomicAdd(&bar[XB_TMO], 1u); break; } }
    }
    nloc = mine > 0u ? mine : 1u; nx = cnt > 0u ? cnt : 1u;
}

__device__ __forceinline__ void xcd_barrier(const XcdBarrier& b) {
    asm volatile("s_waitcnt vmcnt(0)" ::: "memory");
    __syncthreads();
    if (threadIdx.x == 0) {
        unsigned* bar = b.bar;
        __builtin_amdgcn_s_waitcnt(0);
        unsigned nloc = b.st[0], nx = b.st[1];
        if (nloc == 0u) { xcd_barrier_complete(bar, b.x, nloc, nx); b.st[0] = nloc; b.st[1] = nx; }
        const unsigned old = xb_add(&bar[XB_XSUB(b.x)], 1u);
        const unsigned gen = old / nloc;
        if (old + 1u == (gen + 1u) * nloc) {
            __builtin_amdgcn_fence(__ATOMIC_RELEASE, "agent");
            asm volatile("s_waitcnt vmcnt(0)" ::: "memory");
            const unsigned og = xb_add(&bar[XB_TOP], 1u);
            const unsigned tg = og / nx;
            if (og + 1u == (tg + 1u) * nx) xb_add(&bar[XB_TOPGEN], 1u);
            else XB_SPIN(xb_ld(&bar[XB_TOPGEN]) == tg, bar);
            __builtin_amdgcn_fence(__ATOMIC_ACQUIRE, "agent");
            xb_add(&bar[XB_XGEN(b.x)], 1u);
            asm volatile("s_waitcnt vmcnt(0)" ::: "memory");
        } else {
            XB_SPIN(xb_ld(&bar[XB_XGEN(b.x)]) == gen, bar);
            __builtin_amdgcn_fence(__ATOMIC_ACQUIRE, "agent");
            asm volatile("s_waitcnt vmcnt(0)" ::: "memory");
        }
    }
    __syncthreads();
}
__device__ __forceinline__ unsigned short bf16_1(float v) { return (unsigned short)(pk_bf16(v, 0.f) & 0xffffu); }
__device__ __forceinline__ u32x4 pack8(const float (&v)[8]) { u32x4 w; w.x = pk_bf16(v[0], v[1]); w.y = pk_bf16(v[2], v[3]); w.z = pk_bf16(v[4], v[5]); w.w = pk_bf16(v[6], v[7]); return w; }
__device__ __forceinline__ u32x2 pack4(f32x4 v) { u32x2 w; w.x = pk_bf16(v[0], v[1]); w.y = pk_bf16(v[2], v[3]); return w; }
__device__ __forceinline__ bf16x8 lfrag(const LAS unsigned char* p) { return *(const LAS bf16x8*)p; }

__device__ __forceinline__ void phase_o1(const Ctx& C, int i, LAS unsigned char* lds) {
    const int tid = C.tid, lane = tid & 63, wid = tid >> 6, fr = lane & 15, q4 = lane >> 4;
    const bf16_t* __restrict__ proj = (const bf16_t*)(C.ws + WS_R1);
    bf16_t* qn = (bf16_t*)(C.ws + WS_U2); bf16_t* kn = qn + (size_t)T_TOK * 512; bf16_t* vt = kn + (size_t)T_TOK * 512;
    bf16_t* mixed = (bf16_t*)(C.ws + WS_MIXED);
    const bf16_t* wpt = (const bf16_t*)(C.ws + OFF_WX);
    const float* qg = inp(26) + i * 64; const float* kg = inp(27) + i * 64; const float* psc = inp(30) + i * 512;
    for (int bc = C.vb; bc < 256; bc += C.G) {
        const int t0 = bc * 64, b = bc >> 6, c = bc & 63;
        {
            const int sub = tid & 15;
            const f32x4 gq = *(const f32x4*)(qg + sub * 4), gk = *(const f32x4*)(kg + sub * 4);
#pragma unroll 8
            for (int pass = 0; pass < 32; ++pass) {
                const int idx = pass * 32 + (tid >> 4), l = idx >> 4, rem = idx & 15, qk = rem >> 3, h = rem & 7;
                const u32x2 vr = *(const u32x2*)(proj + (size_t)(t0 + l) * LDP_O + qk * 512 + h * 64 + sub * 4);
                const f32x4 v = (f32x4){bf_lo(vr.x), bf_hi(vr.x), bf_lo(vr.y), bf_hi(vr.y)};
                float s = (v[0] * v[0] + v[1] * v[1]) + (v[2] * v[2] + v[3] * v[3]);
                s += __shfl_xor(s, 1); s += __shfl_xor(s, 2); s += __shfl_xor(s, 4); s += __shfl_xor(s, 8);
                const float rs = rsqrtf(s * (1.0f / 64.0f) + EPS) * (qk ? 1.0f : 0.125f);
                const f32x4 gg = qk ? gk : gq;
                *(u32x2*)((qk ? kn : qn) + (size_t)(t0 + l) * 512 + h * 64 + sub * 4) = pack4(v * rs * gg);
            }
        }
        {
            const bf16_t* pv = proj + (size_t)t0 * LDP_O + 1024 + tid;
            bf16_t* dst = vt + ((size_t)(b * 512 + tid)) * SEQ + c * 64;
#pragma unroll 4
            for (int l0 = 0; l0 < 8; ++l0) {
                unsigned v[8];
#pragma unroll
                for (int j = 0; j < 8; ++j) v[j] = pv[(size_t)(l0 * 8 + j) * LDP_O];
                *(u32x4*)(dst + l0 * 8) = (u32x4){v[0] | (v[1] << 16), v[2] | (v[3] << 16), v[4] | (v[5] << 16), v[6] | (v[7] << 16)};
            }
        }
        {
            const int ch = tid, gg = ch >> 7, w = 2 << gg, pos0 = c * 64;
            const bf16_t* pu = proj + (size_t)t0 * LDP_O + 1536 + ch;
            float sum = 0.f;
            if (c > 0) for (int k = 1; k <= w; ++k) sum += bfv(pu[-(long)k * LDP_O]);
#pragma unroll 1
            for (int lb = 0; lb < 64; lb += 16) {
                float uv[16], ov[16];
#pragma unroll
                for (int k = 0; k < 16; ++k) { uv[k] = bfv(pu[(size_t)(lb + k) * LDP_O]); ov[k] = (pos0 + lb + k - w >= 0) ? bfv(pu[((long)(lb + k) - w) * LDP_O]) : 0.f; }
#pragma unroll
                for (int k = 0; k < 16; ++k) {
                    const int l = lb + k, pos = pos0 + l;
                    sum += uv[k]; sum -= ov[k];
                    const int cnt = min(pos + 1, w);
                    ((LAS unsigned short*)lds)[l * 520 + ch] = bf16_1(sum / (float)cnt - uv[k]);
                }
            }
        }
        __syncthreads();
        {
            const int gg = wid >> 1, oh = wid & 1;
            f32x4 acc[4][4];
#pragma unroll
            for (int a = 0; a < 4; ++a)
#pragma unroll
                for (int d = 0; d < 4; ++d) acc[a][d] = (f32x4){0.f, 0.f, 0.f, 0.f};
#pragma unroll
            for (int ks = 0; ks < 4; ++ks) {
                bf16x8 wf[4], pf[4];
#pragma unroll
                for (int ot = 0; ot < 4; ++ot) wf[ot] = *(const bf16x8*)(wpt + ((size_t)(gg * 128 + oh * 64 + ot * 16 + fr)) * 128 + ks * 32 + q4 * 8);
#pragma unroll
                for (int lt = 0; lt < 4; ++lt) pf[lt] = lfrag(lds + ((lt * 16 + fr) * 520 + gg * 128 + ks * 32 + q4 * 8) * 2);
#pragma unroll
                for (int ot = 0; ot < 4; ++ot)
#pragma unroll
                    for (int lt = 0; lt < 4; ++lt) acc[ot][lt] = mfma16(wf[ot], pf[lt], acc[ot][lt]);
            }
#pragma unroll
            for (int ot = 0; ot < 4; ++ot) {
                const int o = oh * 64 + ot * 16 + q4 * 4;
                const f32x4 sc = *(const f32x4*)(psc + gg * 128 + o);
#pragma unroll
                for (int lt = 0; lt < 4; ++lt) *(u32x2*)(mixed + (size_t)(t0 + lt * 16 + fr) * DM + 512 + gg * 128 + o) = pack4(acc[ot][lt] * sc);
            }
        }
        __syncthreads();
    }
}

__device__ __forceinline__ void phase_o2(const Ctx& C, int i, LAS unsigned char* lds) {
    const int tid = C.tid, lane = tid & 63, wid = tid >> 6, fr = lane & 15, q4 = lane >> 4;
    LAS float* bias_s = (LAS float*)lds;
    { const float* rb = inp(28) + (size_t)i * 8 * 257; for (int e = tid; e < 8 * 257; e += 512) bias_s[e] = rb[e]; }
    __syncthreads();
    const bf16_t* __restrict__ qn = (const bf16_t*)(C.ws + WS_U2); const bf16_t* __restrict__ kn = qn + (size_t)T_TOK * 512; const bf16_t* __restrict__ vt = kn + (size_t)T_TOK * 512;
    bf16_t* mixed = (bf16_t*)(C.ws + WS_MIXED);
    const int NW = C.G * 8;
    for (int id = C.vb * 16 + wid; id < 4096; id += ((id & 8) ? NW * 2 - 8 : 8)) {
        const int h = id & 7, qh = (id >> 3) & 1, bc = id >> 4, b = bc >> 6, c = bc & 63, t0 = bc * 64;
        bf16x8 qf[2][2];
#pragma unroll
        for (int qt = 0; qt < 2; ++qt)
#pragma unroll
            for (int ks = 0; ks < 2; ++ks) qf[qt][ks] = *(const bf16x8*)(qn + (size_t)(t0 + qh * 32 + qt * 16 + fr) * 512 + h * 64 + ks * 32 + q4 * 8);
        f32x4 o[4][2];
#pragma unroll
        for (int a = 0; a < 4; ++a) { o[a][0] = (f32x4){0.f, 0.f, 0.f, 0.f}; o[a][1] = (f32x4){0.f, 0.f, 0.f, 0.f}; }
        float mrun[2] = {-1e30f, -1e30f}, lsum[2] = {0.f, 0.f};
        const LAS float* bh = bias_s + h * 257;
        for (int kc = max(0, 8 - c); kc <= 8; ++kc) {
            const int kch = c - 8 + kc; const size_t s0 = (size_t)b * SEQ + kch * 64;
            f32x4 s[4][2];
#pragma unroll
            for (int kt = 0; kt < 4; ++kt) {
                const bf16_t* pk = kn + (s0 + kt * 16 + fr) * 512 + h * 64 + q4 * 8;
                const bf16x8 kf0 = *(const bf16x8*)pk, kf1 = *(const bf16x8*)(pk + 32);
#pragma unroll
                for (int qt = 0; qt < 2; ++qt) s[kt][qt] = mfma16(kf1, qf[qt][1], mfma16(kf0, qf[qt][0], (f32x4){0.f, 0.f, 0.f, 0.f}));
            }
            bf16x8 vfr[2][4];
#pragma unroll
            for (int kk = 0; kk < 2; ++kk)
#pragma unroll
                for (int dt = 0; dt < 4; ++dt) {
                    const bf16_t* pv = vt + ((size_t)(b * 512 + h * 64 + dt * 16 + fr)) * SEQ + kch * 64 + kk * 32 + q4 * 4;
                    const u32x2 lo = *(const u32x2*)pv, hi = *(const u32x2*)(pv + 16);
                    vfr[kk][dt] = as_bf16x8((u32x4){lo.x, lo.y, hi.x, hi.y});
                }
            const int dbase = (8 - kc) * 64;
#pragma unroll
            for (int qt = 0; qt < 2; ++qt) {
                const int lq = qh * 32 + qt * 16 + fr; float mx = -1e30f;
#pragma unroll
                for (int kt = 0; kt < 4; ++kt)
#pragma unroll
                    for (int r = 0; r < 4; ++r) {
                        int dist = dbase + lq - (kt * 16 + q4 * 4 + r); dist = min(max(dist, -128), 128) + 128;
                        const float v = s[kt][qt][r] + bh[dist]; s[kt][qt][r] = v; mx = fmaxf(mx, v);
                    }
                mx = fmaxf(mx, __shfl_xor(mx, 16)); mx = fmaxf(mx, __shfl_xor(mx, 32));
                const float mnew = fmaxf(mrun[qt], mx), alpha = __expf(mrun[qt] - mnew); mrun[qt] = mnew;
                float ps = 0.f;
#pragma unroll
                for (int kt = 0; kt < 4; ++kt)
#pragma unroll
                    for (int r = 0; r < 4; ++r) { const float p = __expf(s[kt][qt][r] - mnew); s[kt][qt][r] = p; ps += p; }
                lsum[qt] = lsum[qt] * alpha + ps;
#pragma unroll
                for (int dt = 0; dt < 4; ++dt) o[dt][qt] *= alpha;
            }
#pragma unroll
            for (int kk = 0; kk < 2; ++kk) {
                bf16x8 pf[2];
#pragma unroll
                for (int qt = 0; qt < 2; ++qt) {
                    u32x4 w; w.x = pk_bf16(s[2 * kk][qt][0], s[2 * kk][qt][1]); w.y = pk_bf16(s[2 * kk][qt][2], s[2 * kk][qt][3]);
                    w.z = pk_bf16(s[2 * kk + 1][qt][0], s[2 * kk + 1][qt][1]); w.w = pk_bf16(s[2 * kk + 1][qt][2], s[2 * kk + 1][qt][3]);
                    pf[qt] = as_bf16x8(w);
                }
#pragma unroll
                for (int dt = 0; dt < 4; ++dt) {
                    const bf16x8 vf = vfr[kk][dt];
#pragma unroll
                    for (int qt = 0; qt < 2; ++qt) o[dt][qt] = mfma16(vf, pf[qt], o[dt][qt]);
                }
            }
        }
#pragma unroll
        for (int qt = 0; qt < 2; ++qt) {
            float ls = lsum[qt]; ls += __shfl_xor(ls, 16); ls += __shfl_xor(ls, 32);
            const float inv = 1.0f / ls; const int lq = qh * 32 + qt * 16 + fr;
#pragma unroll
            for (int dt = 0; dt < 4; ++dt) *(u32x2*)(mixed + (size_t)(t0 + lq) * DM + h * 64 + dt * 16 + q4 * 4) = pack4(o[dt][qt] * inv);
        }
    }
    __syncthreads();
}
constexpr int L_XST = 0, L_BM = 36864, L_CM = 54272, L_BMT = 71680, L_GS = 90112, L_DTS = 126976, L_ACS = 128000;

__device__ __forceinline__ void ssd_stage(const Ctx& C, int i, LAS unsigned char* lds, int bc, int g) {
    const int tid = C.tid, lane = tid & 63, wid = tid >> 6, c = bc & 63;
    const bf16_t* __restrict__ proj = (const bf16_t*)(C.ws + WS_R1);
    const int t0 = bc * 64;
    int cx; if (tid < 256) cx = g * 256 + tid; else if (tid < 384) cx = 512 + g * 128 + (tid - 256); else cx = 768 + g * 128 + (tid - 384);
    const float* cw = inp(8) + (size_t)i * 4096; const float cb = inp(9)[i * 1024 + cx];
    const float w0 = cw[cx], w1 = cw[1024 + cx], w2 = cw[2048 + cx], w3 = cw[3072 + cx];
    const bf16_t* px = proj + (size_t)t0 * LDP_E + 512 + cx;
    float xm3 = 0.f, xm2 = 0.f, xm1 = 0.f;
    if (c > 0) { xm3 = bfv(px[-3 * LDP_E]); xm2 = bfv(px[-2 * LDP_E]); xm1 = bfv(px[-LDP_E]); }
#pragma unroll 4
    for (int l0 = 0; l0 < 8; ++l0) {
        float sv[8];
#pragma unroll
        for (int j = 0; j < 8; ++j) { const float xv = bfv(px[(size_t)(l0 * 8 + j) * LDP_E]); const float v = cb + w0 * xm3 + w1 * xm2 + w2 * xm1 + w3 * xv; sv[j] = silu_f(v); xm3 = xm2; xm2 = xm1; xm1 = xv; }
        const u32x4 w = pack8(sv);
        if (tid < 256) *(LAS u32x4*)(lds + L_XST + tid * 144 + l0 * 16) = w;
        else if (tid < 384) {
            const int n = tid - 256; *(LAS u32x4*)(lds + L_BMT + n * 144 + l0 * 16) = w;
            LAS unsigned short* d = (LAS unsigned short*)(lds + L_BM) + (l0 * 8) * 136 + n;
            d[0] = (unsigned short)(w.x & 0xffffu); d[136] = (unsigned short)(w.x >> 16); d[2 * 136] = (unsigned short)(w.y & 0xffffu); d[3 * 136] = (unsigned short)(w.y >> 16);
            d[4 * 136] = (unsigned short)(w.z & 0xffffu); d[5 * 136] = (unsigned short)(w.z >> 16); d[6 * 136] = (unsigned short)(w.w & 0xffffu); d[7 * 136] = (unsigned short)(w.w >> 16);
        } else {
            const int n = tid - 384;
            LAS unsigned short* d = (LAS unsigned short*)(lds + L_CM) + (l0 * 8) * 136 + n;
            d[0] = (unsigned short)(w.x & 0xffffu); d[136] = (unsigned short)(w.x >> 16); d[2 * 136] = (unsigned short)(w.y & 0xffffu); d[3 * 136] = (unsigned short)(w.y >> 16);
            d[4 * 136] = (unsigned short)(w.z & 0xffffu); d[5 * 136] = (unsigned short)(w.z >> 16); d[6 * 136] = (unsigned short)(w.w & 0xffffu); d[7 * 136] = (unsigned short)(w.w >> 16);
        }
    }
    if (wid < 4) {
        const int hh = g * 4 + wid;
        const float xx = ((const float*)(C.ws + WS_DTR))[(size_t)(t0 + lane) * 8 + hh] + inp(10)[i * 8 + hh];
        const float dtv = xx > 20.f ? xx : log1pf(expf(xx));
        float v = -expf(inp(11)[i * 8 + hh]) * dtv;
#pragma unroll
        for (int off = 1; off < 64; off <<= 1) { const float t = __shfl_up(v, off); if (lane >= off) v += t; }
        ((LAS float*)(lds + L_DTS))[lane * 4 + wid] = dtv; ((LAS float*)(lds + L_ACS))[lane * 4 + wid] = v;
    }
    __syncthreads();
}

__device__ __forceinline__ void ssd_states(const Ctx& C, int i, LAS unsigned char* lds) {
    const int tid = C.tid, lane = tid & 63, wid = tid >> 6, fr = lane & 15, q4 = lane >> 4;
    float* states = (float*)(C.ws + WS_U2); float* cdec = (float*)(C.ws + WS_CDEC);
    const LAS float* DTS = (const LAS float*)(lds + L_DTS); const LAS float* ACS = (const LAS float*)(lds + L_ACS);
    LAS float* WTS = (LAS float*)(lds + L_GS);
    for (int u = C.vb * 2; u < 512; u += ((u & 1) ? C.G * 2 - 1 : 1)) {
        const int g = u & 1, bc = u >> 1;
        ssd_stage(C, i, lds, bc, g);
        if (tid < 256) WTS[tid] = DTS[tid] * expf(ACS[63 * 4 + (tid & 3)] - ACS[tid]);
        if (tid < 4) cdec[bc * 8 + g * 4 + tid] = expf(ACS[63 * 4 + tid]);
        __syncthreads();
        const int j = wid >> 1, nh = wid & 1;
        f32x4 acc[4][4];
#pragma unroll
        for (int a = 0; a < 4; ++a)
#pragma unroll
            for (int d = 0; d < 4; ++d) acc[a][d] = (f32x4){0.f, 0.f, 0.f, 0.f};
#pragma unroll
        for (int ks = 0; ks < 2; ++ks) {
            float wv[8];
#pragma unroll
            for (int e = 0; e < 8; ++e) wv[e] = WTS[(ks * 32 + q4 * 8 + e) * 4 + j];
            bf16x8 af[4];
#pragma unroll
            for (int pt = 0; pt < 4; ++pt) {
                const u32x4 raw = *(const LAS u32x4*)(lds + L_XST + (j * 64 + pt * 16 + fr) * 144 + (ks * 32 + q4 * 8) * 2);
                u32x4 w; w.x = pk_bf16(bf_lo(raw.x) * wv[0], bf_hi(raw.x) * wv[1]); w.y = pk_bf16(bf_lo(raw.y) * wv[2], bf_hi(raw.y) * wv[3]);
                w.z = pk_bf16(bf_lo(raw.z) * wv[4], bf_hi(raw.z) * wv[5]); w.w = pk_bf16(bf_lo(raw.w) * wv[6], bf_hi(raw.w) * wv[7]);
                af[pt] = as_bf16x8(w);
            }
#pragma unroll
            for (int nt = 0; nt < 4; ++nt) {
                const bf16x8 bfr = lfrag(lds + L_BMT + (nh * 64 + nt * 16 + fr) * 144 + (ks * 32 + q4 * 8) * 2);
#pragma unroll
                for (int pt = 0; pt < 4; ++pt) acc[pt][nt] = mfma16(bfr, af[pt], acc[pt][nt]);
            }
        }
        float* st = states + ((size_t)(bc * 8 + g * 4 + j)) * 8192;
#pragma unroll
        for (int pt = 0; pt < 4; ++pt)
#pragma unroll
            for (int nt = 0; nt < 4; ++nt) *(f32x4*)(st + (pt * 16 + fr) * 128 + nh * 64 + nt * 16 + q4 * 4) = acc[pt][nt];
        __syncthreads();
    }
}

__device__ __forceinline__ void ssd_output(const Ctx& C, int i, LAS unsigned char* lds) {
    const int tid = C.tid, lane = tid & 63, wid = tid >> 6, fr = lane & 15, q4 = lane >> 4;
    const bf16_t* __restrict__ proj = (const bf16_t*)(C.ws + WS_R1);
    const bf16_t* __restrict__ hbf = (const bf16_t*)(C.ws + WS_HBF);
    bf16_t* mixed = (bf16_t*)(C.ws + WS_MIXED);
    const LAS float* DTS = (const LAS float*)(lds + L_DTS); const LAS float* ACS = (const LAS float*)(lds + L_ACS);
    LAS float* RED = (LAS float*)(lds + L_BMT);
    for (int u = C.vb * 2; u < 512; u += ((u & 1) ? C.G * 2 - 1 : 1)) {
        const int g = u & 1, bc = u >> 1, t0 = bc * 64;
        ssd_stage(C, i, lds, bc, g);
        {
            const int lt = wid >> 1;
            float dsk[4];
#pragma unroll
            for (int j = 0; j < 4; ++j) dsk[j] = inp(12)[i * 8 + g * 4 + j];
#pragma unroll
            for (int s2 = 0; s2 < 2; ++s2) {
                const int st = (wid & 1) * 2 + s2;
                f32x4 cb = (f32x4){0.f, 0.f, 0.f, 0.f};
#pragma unroll
                for (int ks = 0; ks < 4; ++ks)
                    cb = mfma16(lfrag(lds + L_CM + (lt * 16 + fr) * 272 + (ks * 32 + q4 * 8) * 2), lfrag(lds + L_BM + (st * 16 + fr) * 272 + (ks * 32 + q4 * 8) * 2), cb);
                const int s = st * 16 + fr;
#pragma unroll
                for (int j = 0; j < 4; ++j) {
                    const float as = ACS[s * 4 + j], dts = DTS[s * 4 + j];
#pragma unroll
                    for (int r = 0; r < 4; ++r) {
                        const int l = lt * 16 + q4 * 4 + r; float gv = 0.f;
                        if (s <= l) gv = cb[r] * __expf(ACS[l * 4 + j] - as) * dts;
                        if (s == l) gv += dsk[j];
                        ((LAS unsigned short*)(lds + L_GS))[(j * 64 + l) * 72 + s] = bf16_1(gv);
                    }
                }
            }
        }
        __syncthreads();
        const int j = wid >> 1, ph = wid & 1, hh = g * 4 + j;
        f32x4 a1[4][2], a2[4][2];
#pragma unroll
        for (int a = 0; a < 4; ++a) { a1[a][0] = (f32x4){0.f, 0.f, 0.f, 0.f}; a1[a][1] = a1[a][0]; a2[a][0] = a1[a][0]; a2[a][1] = a1[a][0]; }
#pragma unroll
        for (int ks = 0; ks < 2; ++ks) {
            bf16x8 xf[2], gf[4];
#pragma unroll
            for (int pt = 0; pt < 2; ++pt) xf[pt] = lfrag(lds + L_XST + (j * 64 + ph * 32 + pt * 16 + fr) * 144 + (ks * 32 + q4 * 8) * 2);
#pragma unroll
            for (int lt = 0; lt < 4; ++lt) gf[lt] = lfrag(lds + L_GS + (j * 64 + lt * 16 + fr) * 144 + (ks * 32 + q4 * 8) * 2);
#pragma unroll
            for (int lt = 0; lt < 4; ++lt)
#pragma unroll
                for (int pt = 0; pt < 2; ++pt) a1[lt][pt] = mfma16(xf[pt], gf[lt], a1[lt][pt]);
        }
        const bf16_t* hb = hbf + ((size_t)(bc * 8 + hh)) * 8192;
#pragma unroll
        for (int ks = 0; ks < 4; ++ks) {
            bf16x8 hf[2], cf[4];
#pragma unroll
            for (int pt = 0; pt < 2; ++pt) hf[pt] = *(const bf16x8*)(hb + (ph * 32 + pt * 16 + fr) * 128 + ks * 32 + q4 * 8);
#pragma unroll
            for (int lt = 0; lt < 4; ++lt) cf[lt] = lfrag(lds + L_CM + (lt * 16 + fr) * 272 + (ks * 32 + q4 * 8) * 2);
#pragma unroll
            for (int lt = 0; lt < 4; ++lt)
#pragma unroll
                for (int pt = 0; pt < 2; ++pt) a2[lt][pt] = mfma16(hf[pt], cf[lt], a2[lt][pt]);
        }
#pragma unroll
        for (int lt = 0; lt < 4; ++lt) {
            const int l = lt * 16 + fr; const float ea = __expf(ACS[l * 4 + j]); float q = 0.f;
#pragma unroll
            for (int pt = 0; pt < 2; ++pt) {
                const u32x2 zr = *(const u32x2*)(proj + (size_t)(t0 + l) * LDP_E + hh * 64 + ph * 32 + pt * 16 + q4 * 4);
                const f32x4 zv = (f32x4){bf_lo(zr.x), bf_hi(zr.x), bf_lo(zr.y), bf_hi(zr.y)};
#pragma unroll
                for (int r = 0; r < 4; ++r) { float v = a1[lt][pt][r] + ea * a2[lt][pt][r]; v *= silu_f(zv[r]); a1[lt][pt][r] = v; q += v * v; }
            }
            q += __shfl_xor(q, 16); q += __shfl_xor(q, 32);
            if (q4 == 0) RED[wid * 64 + l] = q;
        }
        __syncthreads();
#pragma unroll
        for (int lt = 0; lt < 4; ++lt) {
            const int l = lt * 16 + fr; float q = 0.f;
#pragma unroll
            for (int w = 0; w < 8; ++w) q += RED[w * 64 + l];
            const float rs = rsqrtf(q * (1.0f / 256.0f) + EPS);
#pragma unroll
            for (int pt = 0; pt < 2; ++pt) {
                const int ch = hh * 64 + ph * 32 + pt * 16 + q4 * 4;
                const f32x4 gn = *(const f32x4*)(inp(13) + i * 512 + ch);
                *(u32x2*)(mixed + (size_t)(t0 + l) * DM + ch) = pack4(a1[lt][pt] * rs * gn);
            }
        }
        __syncthreads();
    }
}

__device__ __forceinline__ void s5_disc(int i, int g, int p, float& abr, float& abi, float& fre, float& fim) {
    const float ar = inp(14)[(i * 32 + g) * 64 + p], ai = inp(15)[(i * 32 + g) * 64 + p];
    const float dt = expf(inp(16)[i * 32 + g]);
    const float em1 = expm1f(dt * ar), th = dt * ai, sn = sinf(th), cs = cosf(th), sh = sinf(0.5f * th);
    const float m1r = em1 * cs - 2.0f * sh * sh;
    abr = 1.0f + m1r; abi = (1.0f + em1) * sn;
    const float den = ar * ar + ai * ai;
    fre = (m1r * ar + abi * ai) / den; fim = (abi * ar - m1r * ai) / den;
}

__device__ __forceinline__ void s5_pass(const Ctx& C, int i, LAS unsigned char* lds, const int mode) {
    const int tid = C.tid, lane = tid & 63, wid = tid >> 6, fr = lane & 15, q4 = lane >> 4;
    const bf16_t* __restrict__ proj = (const bf16_t*)(C.ws + WS_R1);
    f32x2* s5e = (f32x2*)(C.ws + WS_S5E);
    float* ys = (float*)(C.ws + WS_U2); bf16_t* gy = (bf16_t*)(C.ws + WS_U2 + 33554432);
    LAS float* drv = (LAS float*)(lds + wid * 12544);
    LAS unsigned char* drvb = lds + wid * 12544;
    LAS unsigned char* hc = lds + wid * 12544 + 8192;
    const int NW = C.G * 8;
    const bf16x8 zf = as_bf16x8((u32x4){0u, 0u, 0u, 0u});
    int gprev = -1;
    float abr = 0.f, abi = 0.f; bf16x8 bbf[8], cmf[4]; f32x4 dsk = (f32x4){0.f, 0.f, 0.f, 0.f};
#pragma unroll
    for (int e = 0; e < 8; ++e) bbf[e] = zf;
#pragma unroll
    for (int e = 0; e < 4; ++e) cmf[e] = zf;
    for (int unit = C.vb * 8 + wid, it = 0; unit < 8192; unit += NW, ++it) {
        const int g = unit & 31, bc = (C.G == 256) ? (C.vb >> 2) * 4 + it : (unit >> 5), t0 = bc * 64;
        if (g != gprev) {
            gprev = g;
            float fre, fim; s5_disc(i, g, lane, abr, abi, fre, fim);
            const float* pbr = inp(17) + ((size_t)(i * 32 + g) * 64 + lane) * 16; const float* pbi = inp(18) + ((size_t)(i * 32 + g) * 64 + lane) * 16;
            float re[16], im[16];
#pragma unroll
            for (int k = 0; k < 4; ++k) {
                const f32x4 br = *(const f32x4*)(pbr + k * 4), bi = *(const f32x4*)(pbi + k * 4);
#pragma unroll
                for (int e = 0; e < 4; ++e) { re[k * 4 + e] = fre * br[e] - fim * bi[e]; im[k * 4 + e] = fre * bi[e] + fim * br[e]; }
            }
            u32x4 w;
            w.x = pk_bf16(re[0], re[1]); w.y = pk_bf16(re[2], re[3]); w.z = pk_bf16(re[4], re[5]); w.w = pk_bf16(re[6], re[7]); *(LAS u32x4*)(drvb + lane * 32) = w;
            w.x = pk_bf16(re[8], re[9]); w.y = pk_bf16(re[10], re[11]); w.z = pk_bf16(re[12], re[13]); w.w = pk_bf16(re[14], re[15]); *(LAS u32x4*)(drvb + lane * 32 + 16) = w;
            w.x = pk_bf16(im[0], im[1]); w.y = pk_bf16(im[2], im[3]); w.z = pk_bf16(im[4], im[5]); w.w = pk_bf16(im[6], im[7]); *(LAS u32x4*)(drvb + (64 + lane) * 32) = w;
            w.x = pk_bf16(im[8], im[9]); w.y = pk_bf16(im[10], im[11]); w.z = pk_bf16(im[12], im[13]); w.w = pk_bf16(im[14], im[15]); *(LAS u32x4*)(drvb + (64 + lane) * 32 + 16) = w;
#pragma unroll
            for (int pt = 0; pt < 8; ++pt) { const bf16x8 f = lfrag(drvb + (pt * 16 + fr) * 32 + (q4 & 1) * 16); bbf[pt] = (q4 < 2) ? f : zf; }
            if (mode) {
                const float* pcr = inp(19) + ((size_t)(i * 32 + g) * 16 + fr) * 64 + q4 * 8; const float* pci = inp(20) + ((size_t)(i * 32 + g) * 16 + fr) * 64 + q4 * 8;
#pragma unroll
                for (int ks = 0; ks < 2; ++ks) {
                    const f32x4 a = *(const f32x4*)(pcr + ks * 32), b2 = *(const f32x4*)(pcr + ks * 32 + 4), cc = *(const f32x4*)(pci + ks * 32), d2 = *(const f32x4*)(pci + ks * 32 + 4);
                    u32x4 x; x.x = pk_bf16(a[0], a[1]); x.y = pk_bf16(a[2], a[3]); x.z = pk_bf16(b2[0], b2[1]); x.w = pk_bf16(b2[2], b2[3]); cmf[ks] = as_bf16x8(x);
                    u32x4 v; v.x = pk_bf16(-cc[0], -cc[1]); v.y = pk_bf16(-cc[2], -cc[3]); v.z = pk_bf16(-d2[0], -d2[1]); v.w = pk_bf16(-d2[2], -d2[3]); cmf[2 + ks] = as_bf16x8(v);
                }
                dsk = *(const f32x4*)(inp(21) + (size_t)(i * 32 + g) * 16 + q4 * 4);
            }
        }
        bf16x8 uf[4]; f32x4 uu[4];
#pragma unroll
        for (int tb = 0; tb < 4; ++tb) {
            const bf16_t* pu = proj + (size_t)(t0 + tb * 16 + fr) * LDP_E + 1536 + g * 16;
            const bf16x8 x = *(const bf16x8*)(pu + (q4 & 1) * 8);
            uf[tb] = (q4 < 2) ? x : zf;
            const u32x2 ur = *(const u32x2*)(pu + q4 * 4);
            uu[tb] = (f32x4){bf_lo(ur.x), bf_hi(ur.x), bf_lo(ur.y), bf_hi(ur.y)};
        }
        float hr = 0.f, hi = 0.f;
        if (mode) { const f32x2 h0 = s5e[(size_t)(bc * 32 + g) * 64 + lane]; hr = h0.x; hi = h0.y; }
#pragma unroll
        for (int tb = 0; tb < 4; ++tb) {
#pragma unroll
            for (int pt = 0; pt < 8; ++pt) {
                const f32x4 d = mfma16(uf[tb], bbf[pt], (f32x4){0.f, 0.f, 0.f, 0.f});
#pragma unroll
                for (int r = 0; r < 4; ++r) drv[(q4 * 4 + r) * 128 + pt * 16 + fr] = d[r];
            }
#pragma unroll
            for (int tt = 0; tt < 16; ++tt) {
                const float dr = drv[tt * 128 + lane], di = drv[tt * 128 + 64 + lane];
                const float nr = abr * hr - abi * hi + dr, ni = abr * hi + abi * hr + di; hr = nr; hi = ni;
                if (mode) { ((LAS unsigned short*)hc)[tt * 136 + lane] = bf16_1(hr); ((LAS unsigned short*)hc)[tt * 136 + 64 + lane] = bf16_1(hi); }
            }
            if (mode) {
                f32x4 acc = (f32x4){0.f, 0.f, 0.f, 0.f};
#pragma unroll
                for (int ks = 0; ks < 4; ++ks) acc = mfma16(cmf[ks], lfrag(hc + (fr * 136 + ks * 32 + q4 * 8) * 2), acc);
                const int t = tb * 16 + fr;
                const f32x4 y = acc + dsk * uu[tb];
                const size_t o = (size_t)(t0 + t) * 512 + g * 16 + q4 * 4;
                *(f32x4*)(ys + o) = y;
                f32x4 ge;
#pragma unroll
                for (int r = 0; r < 4; ++r) { const float z = 0.7978845608f * (y[r] + 0.044715f * y[r] * y[r] * y[r]); ge[r] = 0.5f * y[r] * (2.0f - 2.0f * __builtin_amdgcn_rcpf(1.0f + __expf(2.0f * z))); }
                *(u32x2*)(gy + o) = pack4(ge);
            }
        }
        if (!mode) s5e[(size_t)(bc * 32 + g) * 64 + lane] = (f32x2){hr, hi};
    }
}

__device__ __forceinline__ void phase_e1(const Ctx& C, int i, LAS unsigned char* lds) { ssd_states(C, i, lds); s5_pass(C, i, lds, 0); __syncthreads(); }
__device__ __forceinline__ void phase_e3(const Ctx& C, int i, LAS unsigned char* lds) { ssd_output(C, i, lds); s5_pass(C, i, lds, 1); __syncthreads(); }

__device__ __forceinline__ void phase_e2(const Ctx& C, int i, bool do_s5 = true) {
    const float* __restrict__ states = (const float*)(C.ws + WS_U2); const float* __restrict__ cdec = (const float*)(C.ws + WS_CDEC);
    bf16_t* __restrict__ hbf = (bf16_t*)(C.ws + WS_HBF);
    for (int idx = C.bid * 512 + C.tid; idx < 131072; idx += C.G * 512) {
        const int n2 = idx & 63, p = (idx >> 6) & 63, h = (idx >> 12) & 7, b = idx >> 15;
        f32x2 run = (f32x2){0.f, 0.f};
#pragma unroll 8
        for (int c = 0; c < 64; ++c) {
            const size_t un = (size_t)((b * 64 + c) * 8 + h), o = un * 8192 + p * 128 + n2 * 2;
            const f32x2 s = *(const f32x2*)(states + o); const float d = cdec[un];
            *(unsigned*)(hbf + o) = pk_bf16(run.x, run.y);
            run = run * d + s;
        }
    }
    f32x2* s5e = (f32x2*)(C.ws + WS_S5E);
    if (do_s5)
    for (int idx = C.bid * 512 + C.tid; idx < 8192; idx += C.G * 512) {
        const int p = idx & 63, g = (idx >> 6) & 31, b = idx >> 11;
        float ar, ai, fre, fim; s5_disc(i, g, p, ar, ai, fre, fim);
#pragma unroll
        for (int k = 0; k < 6; ++k) { const float nr = ar * ar - ai * ai, ni = 2.0f * ar * ai; ar = nr; ai = ni; }
        float hr = 0.f, hi = 0.f;
        f32x2* e0 = s5e + (size_t)(b * 64 * 32 + g) * 64 + p;
#pragma unroll 1
        for (int c0 = 0; c0 < 64; c0 += 16) {
            f32x2 s[16];
#pragma unroll
            for (int k = 0; k < 16; ++k) s[k] = e0[(size_t)(c0 + k) * 2048];
#pragma unroll
            for (int k = 0; k < 16; ++k) {
                e0[(size_t)(c0 + k) * 2048] = (f32x2){hr, hi};
                const float nr = ar * hr - ai * hi + s[k].x, ni = ar * hi + ai * hr + s[k].y; hr = nr; hi = ni;
            }
        }
    }
}
enum { OP_CONV = 0, OP_GU, OP_DOWN, OP_IN, OP_E1, OP_E2, OP_E3, OP_GLU, OP_O1, OP_O2, OP_OUT };
constexpr int N_PHASES = 40;

__global__ void __launch_bounds__(512, 2) fwd_kernel(Params P) {
    extern __shared__ __attribute__((aligned(16))) unsigned char lds_raw[];
    LAS unsigned char* lds = (LAS unsigned char*)lds_raw;
    cg::grid_group grid = cg::this_grid();
    if (threadIdx.x < 4) ((LAS unsigned*)(lds + 131072))[threadIdx.x] = 0u;
    __syncthreads();
    const XcdBarrier xbar = xcd_barrier_post((unsigned*)(P.ws + WS_BAR), (volatile LAS unsigned*)(lds + 131072));
    unsigned char* ws = P.ws;
    float* ssb = (float*)(ws + WS_SS);
    bf16_t* xb = (bf16_t*)(ws + WS_XB);
    bf16_t* mixed = (bf16_t*)(ws + WS_MIXED);
#ifdef REP_MASK
    for (int pp = 2 * P.ph_lo; pp < 2 * P.ph_hi; ++pp) {
        const int ph = pp >> 1, rep = pp & 1;
#else
    for (int ph = P.ph_lo; ph < P.ph_hi; ++ph) {
#endif
        Ctx C; { int t_ = threadIdx.x, b_ = blockIdx.x, g_ = gridDim.x; asm volatile("" : "+v"(t_), "+s"(b_), "+s"(g_)); unsigned char* w_ = P.ws; float* o_ = P.out; asm volatile("" : "+s"(w_), "+s"(o_)); C.out = o_; C.ws = w_; C.tid = t_; C.bid = b_; C.G = g_; C.wk = b_; C.nw = g_; C.vb = (g_ & 7) == 0 ? (b_ & 7) * (g_ >> 3) + (b_ >> 3) : b_; }
        int layer, sub;
        if (ph < 11) { layer = 0; sub = ph; } else if (ph < 20) { layer = 1; sub = ph - 11; } else if (ph < 31) { layer = 2; sub = ph - 20; } else { layer = 3; sub = ph - 31; }
        const bool even = (layer & 1) == 0; const int i = layer >> 1;
        int op, which = 0;
        if (sub <= 3) { op = sub == 0 ? OP_CONV : sub == 1 ? OP_GU : sub == 2 ? OP_DOWN : OP_IN; }
        else if (even) { op = sub == 4 ? OP_E1 : sub == 5 ? OP_E2 : sub == 6 ? OP_E3 : sub == 7 ? OP_GLU : sub == 8 ? OP_OUT : sub == 9 ? OP_GU : OP_DOWN; which = sub >= 9; }
        else { op = sub == 4 ? OP_O1 : sub == 5 ? OP_O2 : sub == 6 ? OP_OUT : sub == 7 ? OP_GU : OP_DOWN; which = sub >= 7; }
#ifdef REP_MASK
        const bool masked = ((REP_MASK >> op) & 1) != 0;
        if (rep == 1 && !masked) continue;
#endif
        switch (op) {
        case OP_CONV: phase_convert(C, layer, lds, (C.G == 256) ? (1 | 8 | 16) : 31); break;
        case OP_GU: {
            EpiGateUp E{(bf16_t*)(ws + WS_R1), ssb, (const LAS float*)(lds + LDS_RS), 0};
            run_gemm(C, lds, xb, (const bf16_t*)(ws + (which ? OFF_GU2 : OFF_GU1)), T_TOK, 2 * FF, DM, E);
            if (C.G == 256 && C.bid >= 128) { Ctx C2 = C; C2.wk = C.bid - 128; C2.nw = 128; phase_convert(C2, layer, lds, which ? 4 : 2); }
        } break;
        case OP_DOWN: case OP_OUT: {
            const bool dn = (op == OP_DOWN);
            float osc = 1.0f;
#ifdef SKIP_EVEN
            if (even) osc = 0.f;
#endif
#ifdef SKIP_ODD
            if (!even) osc = 0.f;
#endif
            float rsc = dn ? 0.5f : osc;
#ifdef REP_MASK
            if (masked && rep == 0) rsc = 0.f;
#endif
            EpiResid E{(ph == N_PHASES - 1) ? P.out : (float*)nullptr, xb, ssb, rsc};
            const bf16_t* A = dn ? (const bf16_t*)(ws + WS_R1) : mixed;
            const bf16_t* Bt = (const bf16_t*)(ws + (dn ? (which ? OFF_D2 : OFF_D1) : OFF_WOUT));
            run_gemm(C, lds, A, Bt, T_TOK, DM, dn ? FF : DM, E);
        } break;
        case OP_IN: {
            EpiProj E{(bf16_t*)(ws + WS_R1), ssb, even ? (float*)(ws + WS_DTR) : (float*)nullptr, even ? LDP_E : LDP_O, even ? LDP_E : LDP_O, (const LAS float*)(lds + LDS_RS), 0};
            run_gemm(C, lds, xb, (const bf16_t*)(ws + OFF_WIN), T_TOK, even ? 2304 : 2048, DM, E);
        } break;
#ifndef SKIP_EVEN
        case OP_E1: phase_e1(C, i, lds); break;
#ifdef REP_MASK
        case OP_E2: phase_e2(C, i, rep == 0); break;
#else
        case OP_E2: phase_e2(C, i); break;
#endif
        case OP_E3: phase_e3(C, i, lds); break;
#endif
#ifndef SKIP_EVEN
        case OP_GLU: {
            EpiGlu E{mixed, (const float*)(ws + WS_U2), inp(23) + i * 512};
            run_gemm(C, lds, (const bf16_t*)(ws + WS_U2 + 33554432), (const bf16_t*)(ws + OFF_WX), T_TOK, 512, 512, E);
        } break;
#endif
#ifndef SKIP_ODD
        case OP_O1: phase_o1(C, i, lds); break;
        case OP_O2: phase_o2(C, i, lds); break;
#endif
        }
#ifdef REP_MASK
        if (rep == 0 && masked) continue;
#endif
        if (ph + 1 < P.ph_hi) {
            if (P.ph_hi < 0) grid.sync();
            xcd_barrier(xbar);
#ifdef DOUBLE_BAR
            xcd_barrier(xbar); xcd_barrier(xbar);
#endif
        }
    }
}

extern "C" void kernel_launch(void* const* d_in, const int* in_sizes, int n_in, void* d_out, int out_size, void* d_ws, size_t ws_size, hipStream_t stream) {
    static int grid_blocks = 0;
    if (!grid_blocks) {
        int dev = 0, cus = 0, per_cu = 0;
        hipGetDevice(&dev);
        hipDeviceGetAttribute(&cus, hipDeviceAttributeMultiprocessorCount, dev);
        hipFuncSetAttribute((const void*)fwd_kernel, hipFuncAttributeMaxDynamicSharedMemorySize, LDS_BYTES);
        hipOccupancyMaxActiveBlocksPerMultiprocessor(&per_cu, (const void*)fwd_kernel, 512, LDS_BYTES);
        if (per_cu < 1) per_cu = 1;
        grid_blocks = cus * 1;
        if (n_in != 35 || ws_size < WS_END) fprintf(stderr, "kernel_launch: unexpected n_in %d / ws_size %zu (need %zu)\n", n_in, ws_size, (size_t)WS_END);
    }
    (void)hipMemsetAsync((char*)d_ws + WS_BAR, 0, XCD_BAR_WORDS * 4, stream);
    Params p{};
    for (int k = 0; k < 35; ++k) p.in[k] = (const float*)d_in[k];
    p.out = (float*)d_out; p.ws = (unsigned char*)d_ws; p.ph_lo = 0; p.ph_hi = N_PHASES;
    void* args[] = {&p};
    hipError_t e = hipLaunchCooperativeKernel((const void*)fwd_kernel, dim3(grid_blocks), dim3(512), args, LDS_BYTES, stream);
    if (e != hipSuccess) fprintf(stderr, "cooperative launch failed: %s (grid %d)\n", hipGetErrorString(e), grid_blocks);
}
```

```cpp
#include <hip/hip_runtime.h>
#include <hip/hip_cooperative_groups.h>
#include <cstdio>
namespace cg = cooperative_groups;

#define LAS __attribute__((address_space(3)))
typedef float f32x2 __attribute__((ext_vector_type(2)));
typedef unsigned u32x2 __attribute__((ext_vector_type(2)));

namespace pg8 {
#define PG8_LAS __attribute__((address_space(3)))
typedef unsigned short bf16_t;
typedef short bf16x8 __attribute__((ext_vector_type(8)));
typedef float f32x4 __attribute__((ext_vector_type(4)));
typedef unsigned u32x4 __attribute__((ext_vector_type(4)));
constexpr int BM = 256, BK = 64, HALF = 128, HTB = HALF * BK * 2  , STAGE_BYTES = 8 * HTB, NXCD = 8, WGM = 8;

__host__ __device__ __forceinline__ int lds_byte(int r, int c) { const int st = (r >> 4) * 2 + (c >> 5), rr = r & 15, cc = c & 31, ob = rr * 64 + cc * 2; return st * 1024 + (ob ^ (((ob >> 9) & 1) << 5)); }
__host__ __device__ __forceinline__ void stage_rc(int b, int& R, int& C) { const int st = b / 1024, sb = b % 1024, swz = sb ^ (((sb >> 9) & 1) << 5); R = (st >> 1) * 16 + swz / 64; C = (st & 1) * 32 + (swz % 64) / 2; }
__host__ __device__ __forceinline__ int perm32(int rho) { const int n = rho >> 4, i = rho & 15; return 8 * (i >> 2) + 4 * n + (i & 3); }

struct Unit { int pm, pn; };
struct Gemm { const bf16_t* A; const bf16_t* Bt; int M, N, K; };

struct StaticOrder {
    int nM, nN, nwg, G, c;
    __host__ __device__ void init(int M, int N, int G_, int c_) { nM = M / BM; nN = N / BM; nwg = nM * nN; G = G_; c = c_; }
    __host__ __device__ bool next(int i, Unit& u) const {
        const long L = (long)i * G + c; if (L >= nwg) return false;
        int wgid = (int)L; { const int q = nwg / NXCD, r = nwg % NXCD, xcd = wgid % NXCD, off = wgid / NXCD; wgid = (xcd < r ? xcd * (q + 1) : r * (q + 1) + (xcd - r) * q) + off; }
        const int nig = WGM * nN, gid = wgid / nig, fm = gid * WGM, gsz = (nM - fm) < WGM ? (nM - fm) : WGM;
        u.pm = fm + ((wgid % nig) % gsz); u.pn = (wgid % nig) / gsz; return true;
    }
    __device__ __forceinline__ void a_ready(const Unit&) const {}
    __device__ __forceinline__ void done(const Unit&) const {}
};
template <class Epi, class Sched, bool STAMP = false>
__device__ __forceinline__ void gemm_phase(PG8_LAS unsigned char* lds, const Gemm g, const Sched& S, const Epi& E, unsigned long long* stamps) {
    int tid_l = threadIdx.x; asm volatile("" : "+v"(tid_l));
    const int tid = tid_l, wid = __builtin_amdgcn_readfirstlane(tid >> 6), lane = tid & 63, wr = wid >> 2, wc = wid & 3, fr = lane & 15, fq = lane >> 4;
    const int K = g.K, nt = K / BK;
    int ts_lo = 0, ts_hi = 0, nts = 0; const unsigned long long rt_entry = STAMP ? (unsigned long long)wall_clock64() : 0ull;
#define PG8_STAMP() do { if (STAMP && wid == 0 && nts < 64) { const unsigned long long _c = (unsigned long long)clock64(); \
        ts_lo = (lane == nts) ? (int)(unsigned)_c : ts_lo; ts_hi = (lane == nts) ? (int)(unsigned)(_c >> 32) : ts_hi; ++nts; } } while (0)
    PG8_STAMP();
    unsigned voffA[2], voffB[2];
#pragma unroll
    for (int i = 0; i < 2; ++i) { int R, C; stage_rc(tid * 16 + i * 8192, R, C); const int Rb = Epi::PERM ? ((R & ~31) + perm32(R & 31)) : R;
        voffA[i] = (unsigned)(R * K + C) * 2u; voffB[i] = (unsigned)(Rb * K + C) * 2u; }
    const size_t kstep = (size_t)(BK * 2);
    const size_t hstep = (size_t)HALF * K * 2;
    const size_t tstep = 2 * hstep;
    const unsigned ldsw = (unsigned)wid * 1024u;
    const int aoff = lds_byte(wr * 64 + fr, fq * 8), boff = lds_byte(wc * 32 + fr, fq * 8);
#define PG8_SA(b, h) (((b) * 2 + (h)) * HTB)
#define PG8_SB(b, h) ((4 + (b) * 2 + (h)) * HTB)
#define PG8_STAGE(bufoff, gbase, voff) do { _Pragma("unroll") for (int _i = 0; _i < 2; ++_i) \
        __builtin_amdgcn_global_load_lds((const unsigned*)((const char*)(gbase) + (voff)[_i]), (PG8_LAS unsigned*)(lds + (bufoff) + ldsw + _i * 8192), 16, 0, 0); } while (0)
#define PG8_LDA(dst, b, h) do { _Pragma("unroll") for (int m = 0; m < 4; ++m) _Pragma("unroll") for (int k = 0; k < 2; ++k) dst[m][k] = *(const PG8_LAS bf16x8*)(lds + PG8_SA(b, h) + aoff + m * 2048 + k * 1024); } while (0)
#define PG8_LDB(dst, b, h) do { _Pragma("unroll") for (int n = 0; n < 2; ++n) _Pragma("unroll") for (int k = 0; k < 2; ++k) dst[n][k] = *(const PG8_LAS bf16x8*)(lds + PG8_SB(b, h) + boff + n * 2048 + k * 1024); } while (0)
#define PG8_MMA(ai, bj, At, Bt) do { __builtin_amdgcn_s_setprio(1); _Pragma("unroll") for (int m = 0; m < 4; ++m) _Pragma("unroll") for (int n = 0; n < 2; ++n) _Pragma("unroll") for (int k = 0; k < 2; ++k) \
        acc[ai][bj][m][n] = __builtin_amdgcn_mfma_f32_16x16x32_bf16(Bt[n][k], At[m][k], acc[ai][bj][m][n], 0, 0, 0); __builtin_amdgcn_s_setprio(0); } while (0)
#define PG8_WAIT_V(n) asm volatile("s_waitcnt vmcnt(" #n ")" ::: "memory")
#define PG8_WAIT_L(n) asm volatile("s_waitcnt lgkmcnt(" #n ")" ::: "memory")
#define PG8_BAR __builtin_amdgcn_s_barrier()
#define PG8_SCHED __builtin_amdgcn_sched_barrier(0)
    Unit cur, nxt; int ui = 0;
    if (!S.next(0, cur)) return;
    f32x4 acc[2][2][4][2];
#pragma unroll
    for (int a = 0; a < 2; ++a)
#pragma unroll
        for (int b = 0; b < 2; ++b)
#pragma unroll
            for (int m = 0; m < 4; ++m)
#pragma unroll
                for (int n = 0; n < 2; ++n) acc[a][b][m][n] = (f32x4){0.f, 0.f, 0.f, 0.f};
    bf16x8 At[4][2], B0[2][2], B1[2][2];
    const char* cA = (const char*)g.A + (size_t)cur.pm * tstep; const char* cB = (const char*)g.Bt + (size_t)cur.pn * tstep;
    S.a_ready(cur);
    PG8_STAGE(PG8_SB(0, 0), cB, voffB); PG8_STAGE(PG8_SA(0, 0), cA, voffA); PG8_STAGE(PG8_SB(0, 1), cB + hstep, voffB); PG8_STAGE(PG8_SA(0, 1), cA + hstep, voffA);
    if (wr == 1) PG8_BAR;
    PG8_WAIT_V(4); PG8_BAR;
    PG8_STAGE(PG8_SB(1, 0), cB + kstep, voffB); PG8_STAGE(PG8_SA(1, 0), cA + kstep, voffA); PG8_STAGE(PG8_SB(1, 1), cB + hstep + kstep, voffB);
    PG8_WAIT_V(6); PG8_BAR;
    PG8_STAMP();
    for (;;) {
        const bool has_next = S.next(ui + 1, nxt);
        const char* nA = has_next ? (const char*)g.A + (size_t)nxt.pm * tstep : cA; const char* nB = has_next ? (const char*)g.Bt + (size_t)nxt.pn * tstep : cB;
        for (int t = 0; t < nt; t += 2) {
            const bool last = (t == nt - 2);
            const char* a1 = cA + (size_t)(t + 1) * kstep;
            const char* a2 = last ? nA : cA + (size_t)(t + 2) * kstep; const char* b2 = last ? nB : cB + (size_t)(t + 2) * kstep;
            const char* a3 = a2 + kstep; const char* b3 = b2 + kstep;
            if (last && has_next) S.a_ready(nxt);
            PG8_LDB(B0, 0, 0); PG8_SCHED; PG8_LDA(At, 0, 0); PG8_STAGE(PG8_SA(1, 1), a1 + hstep, voffA);
            PG8_WAIT_L(8); PG8_BAR; PG8_WAIT_L(0); PG8_MMA(0, 0, At, B0); PG8_BAR; PG8_SCHED;
            PG8_LDB(B1, 0, 1); PG8_STAGE(PG8_SB(0, 0), b2, voffB);
            PG8_BAR; PG8_WAIT_L(0); PG8_MMA(0, 1, At, B1); PG8_BAR;
            PG8_LDA(At, 0, 1); PG8_STAGE(PG8_SA(0, 0), a2, voffA);
            PG8_BAR; PG8_WAIT_L(0); PG8_MMA(1, 0, At, B0); PG8_BAR; PG8_SCHED;
            PG8_STAGE(PG8_SB(0, 1), b2 + hstep, voffB);
            PG8_WAIT_V(6); PG8_BAR; PG8_MMA(1, 1, At, B1); PG8_BAR;
            PG8_LDB(B0, 1, 0); PG8_SCHED; PG8_LDA(At, 1, 0); PG8_STAGE(PG8_SA(0, 1), a2 + hstep, voffA);
            PG8_WAIT_L(8); PG8_BAR; PG8_WAIT_L(0); PG8_MMA(0, 0, At, B0); PG8_BAR; PG8_SCHED;
            PG8_LDB(B1, 1, 1); PG8_STAGE(PG8_SB(1, 0), b3, voffB);
            PG8_BAR; PG8_WAIT_L(0); PG8_MMA(0, 1, At, B1); PG8_BAR;
            PG8_LDA(At, 1, 1); PG8_STAGE(PG8_SA(1, 0), a3, voffA);
            PG8_BAR; PG8_WAIT_L(0); PG8_MMA(1, 0, At, B0); PG8_BAR; PG8_SCHED;
            PG8_STAGE(PG8_SB(1, 1), b3 + hstep, voffB);
            PG8_WAIT_V(6); PG8_BAR; PG8_MMA(1, 1, At, B1); PG8_BAR;
        }
        PG8_STAMP();
        if constexpr (!Epi::AFTER_DRAIN) { E(acc, cur, wr, wc, fr, fq); S.done(cur); }
        PG8_STAMP();
        if (!has_next) break;
#pragma unroll
        for (int a = 0; a < 2; ++a)
#pragma unroll
            for (int b = 0; b < 2; ++b)
#pragma unroll
                for (int m = 0; m < 4; ++m)
#pragma unroll
                    for (int n = 0; n < 2; ++n) acc[a][b][m][n] = (f32x4){0.f, 0.f, 0.f, 0.f};
        cur = nxt; cA = nA; cB = nB; ++ui;
    }
    PG8_WAIT_V(0);
    if (wr == 0) PG8_BAR;
    PG8_BAR;
    if constexpr (Epi::AFTER_DRAIN) { E.fused(acc, cur, wr, wc, fr, fq, lds, wid, lane); S.done(cur); }
    PG8_STAMP();
    if (STAMP && wid == 0) { stamps[lane] = lane < nts ? (((unsigned long long)(unsigned)ts_hi << 32) | (unsigned)ts_lo) : 0ull;
        if (lane == 62) stamps[62] = rt_entry; if (lane == 63) stamps[63] = (unsigned long long)wall_clock64(); }
#undef PG8_STAMP
#undef PG8_SA
#undef PG8_SB
#undef PG8_STAGE
#undef PG8_LDA
#undef PG8_LDB
#undef PG8_MMA
#undef PG8_WAIT_V
#undef PG8_WAIT_L
#undef PG8_BAR
#undef PG8_SCHED
}
}
using pg8::bf16_t; using pg8::bf16x8; using pg8::f32x4; using pg8::u32x4;

constexpr int T_TOK = 16384, DM = 1024, FF = 2816, SEQ = 4096, NCH = 64;
constexpr float EPS = 1e-6f;
constexpr int LDP_E = 2056, LDP_O = 2048;
constexpr size_t OFF_GU1 = 0, OFF_D1 = 11534336, OFF_GU2 = 17301504, OFF_D2 = 28835840, OFF_WIN = 34603008, OFF_WOUT = 39321600, OFF_WX = 41418752;
constexpr size_t WS_XB = 41943040, WS_R1 = 75497472, WS_MIXED = 210239488, WS_U2 = 243793920, WS_HBF = 310902784, WS_S5E = 344457216, WS_SS = 348651520, WS_CDEC = 349503488, WS_BAR = 349511680, WS_DTR = 349511680 + 16384, WS_END = 349511680 + 16384 + 524288;
constexpr int LDS_RS = 131072 + 16, LDS_BYTES = LDS_RS + 8 * 256 * 4;

struct Params { const float* in[35]; float* out; unsigned char* ws; int ph_lo, ph_hi; };
typedef const float* cfp_t;
__device__ __forceinline__ const float* inp(int k) { asm volatile("" : "+s"(k)); return ((const __attribute__((address_space(4))) cfp_t*)__builtin_amdgcn_kernarg_segment_ptr())[k]; }
struct Ctx { float* out; unsigned char* ws; int tid, bid, G, wk, nw, vb; };

__device__ __forceinline__ unsigned pk_bf16(float lo, float hi) { unsigned r; asm("v_cvt_pk_bf16_f32 %0, %1, %2" : "=v"(r) : "v"(lo), "v"(hi)); return r; }
__device__ __forceinline__ float bfv(unsigned short v) { return __uint_as_float((unsigned)v << 16); }
__device__ __forceinline__ float bf_lo(unsigned w) { return __uint_as_float(w << 16); }
__device__ __forceinline__ float bf_hi(unsigned w) { return __uint_as_float(w & 0xffff0000u); }
__device__ __forceinline__ float silu_f(float v) { return v * __builtin_amdgcn_rcpf(1.0f + __expf(-v)); }
__device__ __forceinline__ f32x4 mfma16(bf16x8 a, bf16x8 b, f32x4 c) { return __builtin_amdgcn_mfma_f32_16x16x32_bf16(a, b, c, 0, 0, 0); }
__device__ __forceinline__ bf16x8 as_bf16x8(u32x4 w) { return __builtin_bit_cast(bf16x8, w); }
__device__ __forceinline__ u32x4 as_u32x4(bf16x8 w) { return __builtin_bit_cast(u32x4, w); }

struct EpiGateUp {
    static constexpr bool PERM = true, AFTER_DRAIN = false;
    static constexpr bool NEED_RS = true;
    bf16_t* O; const float* ss; const LAS float* rst; mutable int k;
    __device__ __forceinline__ void operator()(const f32x4 (&acc)[2][2][4][2], const pg8::Unit& u, int wr, int wc, int fr, int fq) const {
        const int slot = k++;
        const int row0 = u.pm * 256 + wr * 64 + fr, col0 = u.pn * 128 + wc * 32 + 8 * fq;
#pragma unroll
        for (int ai = 0; ai < 2; ++ai)
#pragma unroll
            for (int m = 0; m < 4; ++m) {
                const int r = row0 + ai * 128 + m * 16;
                float rs;
                if (slot < 8) rs = rst[slot * 256 + (r & 255)];
                else { const f32x4 sp = *(const f32x4*)(ss + (size_t)r * 4); rs = rsqrtf(((sp[0] + sp[1]) + (sp[2] + sp[3])) * (1.0f / 1024.0f) + EPS); }
                float a[8];
                const float k1 = -1.44269504f * rs, rs2 = rs * rs;
#pragma unroll
                for (int n = 0; n < 2; ++n)
#pragma unroll
                    for (int h = 0; h < 2; ++h) {
                        const f32x2 ag = (f32x2){acc[ai][0][m][n][2 * h], acc[ai][0][m][n][2 * h + 1]}, au = (f32x2){acc[ai][1][m][n][2 * h], acc[ai][1][m][n][2 * h + 1]};
                        const f32x2 t = ag * k1; f32x2 e; e.x = __builtin_amdgcn_exp2f(t.x); e.y = __builtin_amdgcn_exp2f(t.y);
                        const f32x2 d = e + 1.0f; f32x2 r; r.x = __builtin_amdgcn_rcpf(d.x); r.y = __builtin_amdgcn_rcpf(d.y);
                        const f32x2 o = (ag * au) * (r * rs2);
                        a[n * 4 + 2 * h] = o.x; a[n * 4 + 2 * h + 1] = o.y;
                    }
                u32x4 w; w.x = pk_bf16(a[0], a[1]); w.y = pk_bf16(a[2], a[3]); w.z = pk_bf16(a[4], a[5]); w.w = pk_bf16(a[6], a[7]);
                *(u32x4*)(O + (size_t)r * FF + col0) = w;
            }
    }
};
struct EpiResid {
    static constexpr bool PERM = true, AFTER_DRAIN = true;
    static constexpr bool NEED_RS = false;
    float* xout; bf16_t* xb; float* ssn; float scale;
    __device__ __forceinline__ void fused(f32x4 (&acc)[2][2][4][2], const pg8::Unit& u, int wr, int wc, int fr, int fq, LAS unsigned char* lds, int wid, int lane) const {
        const int row0 = u.pm * 256 + wr * 64 + fr, col0 = u.pn * 256 + wc * 32 + 8 * fq;
        LAS float* Pq = (LAS float*)lds;
#pragma unroll
        for (int ai = 0; ai < 2; ++ai)
#pragma unroll
            for (int m = 0; m < 4; ++m) {
                const int r = row0 + ai * 128 + m * 16; float q = 0.f;
#pragma unroll
                for (int bj = 0; bj < 2; ++bj) {
                    const size_t o = (size_t)r * DM + col0 + bj * 128;
                    const u32x4 xo = *(const u32x4*)(xb + o);
                    f32x4 v0 = (f32x4){bf_lo(xo.x), bf_hi(xo.x), bf_lo(xo.y), bf_hi(xo.y)}, v1 = (f32x4){bf_lo(xo.z), bf_hi(xo.z), bf_lo(xo.w), bf_hi(xo.w)};
                    v0 += acc[ai][bj][m][0] * scale; v1 += acc[ai][bj][m][1] * scale;
                    if (xout) { *(f32x4*)(xout + o) = v0; *(f32x4*)(xout + o + 4) = v1; }
                    u32x4 w; w.x = pk_bf16(v0[0], v0[1]); w.y = pk_bf16(v0[2], v0[3]); w.z = pk_bf16(v1[0], v1[1]); w.w = pk_bf16(v1[2], v1[3]);
                    *(u32x4*)(xb + o) = w;
                    const float r0 = bf_lo(w.x), r1 = bf_hi(w.x), r2 = bf_lo(w.y), r3 = bf_hi(w.y), r4 = bf_lo(w.z), r5 = bf_hi(w.z), r6 = bf_lo(w.w), r7 = bf_hi(w.w);
                    q += ((r0 * r0 + r1 * r1) + (r2 * r2 + r3 * r3)) + ((r4 * r4 + r5 * r5) + (r6 * r6 + r7 * r7));
                }
                q += __shfl_xor(q, 16); q += __shfl_xor(q, 32);
                if (fq == 0) Pq[(ai * 128 + wr * 64 + m * 16 + fr) * 4 + wc] = q;
            }
        asm volatile("s_waitcnt lgkmcnt(0)" ::: "memory"); __builtin_amdgcn_s_barrier(); asm volatile("" ::: "memory");
        const int t = wid * 64 + lane;
        if (t < 256) { const f32x4 p = *(const LAS f32x4*)(Pq + t * 4); ssn[(size_t)(u.pm * 256 + t) * 4 + u.pn] = (p[0] + p[1]) + (p[2] + p[3]); }
    }
};
struct EpiProj {
    static constexpr bool PERM = true, AFTER_DRAIN = false;
    static constexpr bool NEED_RS = true;
    bf16_t* O; const float* ss; float* dtr; int ld, ncv; const LAS float* rst; mutable int k;
    __device__ __forceinline__ void operator()(const f32x4 (&acc)[2][2][4][2], const pg8::Unit& u, int wr, int wc, int fr, int fq) const {
        const int slot = k++;
        const int row0 = u.pm * 256 + wr * 64 + fr, col0 = u.pn * 256 + wc * 32 + 8 * fq;
#pragma unroll
        for (int ai = 0; ai < 2; ++ai)
#pragma unroll
            for (int m = 0; m < 4; ++m) {
                const int r = row0 + ai * 128 + m * 16;
                float rs;
                if (slot < 8) rs = rst[slot * 256 + (r & 255)];
                else { const f32x4 sp = *(const f32x4*)(ss + (size_t)r * 4); rs = rsqrtf(((sp[0] + sp[1]) + (sp[2] + sp[3])) * (1.0f / 1024.0f) + EPS); }
#pragma unroll
                for (int bj = 0; bj < 2; ++bj) {
                    const int c = col0 + bj * 128;
                    if (c < ncv) {
                        const f32x4 v0 = acc[ai][bj][m][0] * rs, v1 = acc[ai][bj][m][1] * rs;
                        u32x4 w; w.x = pk_bf16(v0[0], v0[1]); w.y = pk_bf16(v0[2], v0[3]); w.z = pk_bf16(v1[0], v1[1]); w.w = pk_bf16(v1[2], v1[3]);
                        *(u32x4*)(O + (size_t)r * ld + c) = w;
                        if (dtr && c == 2048) { *(f32x4*)(dtr + (size_t)r * 8) = v0; *(f32x4*)(dtr + (size_t)r * 8 + 4) = v1; }
                    }
                }
            }
    }
};
struct EpiGlu {
    static constexpr bool PERM = true, AFTER_DRAIN = false;
    static constexpr bool NEED_RS = false;
    bf16_t* O; const float* ys; const float* bias;
    __device__ __forceinline__ void operator()(const f32x4 (&acc)[2][2][4][2], const pg8::Unit& u, int wr, int wc, int fr, int fq) const {
        const int row0 = u.pm * 256 + wr * 64 + fr, col0 = u.pn * 256 + wc * 32 + 8 * fq;
#pragma unroll
        for (int ai = 0; ai < 2; ++ai)
#pragma unroll
            for (int m = 0; m < 4; ++m) {
                const int r = row0 + ai * 128 + m * 16;
#pragma unroll
                for (int bj = 0; bj < 2; ++bj) {
                    const int c = col0 + bj * 128; float a[8];
#pragma unroll
                    for (int n = 0; n < 2; ++n) {
                        const f32x4 bv = *(const f32x4*)(bias + c + 4 * n), yv = *(const f32x4*)(ys + (size_t)r * 512 + c + 4 * n);
#pragma unroll
                        for (int j = 0; j < 4; ++j) { const float gt = acc[ai][bj][m][n][j] + bv[j]; a[n * 4 + j] = yv[j] * __builtin_amdgcn_rcpf(1.0f + __expf(-gt)); }
                    }
                    u32x4 w; w.x = pk_bf16(a[0], a[1]); w.y = pk_bf16(a[2], a[3]); w.z = pk_bf16(a[4], a[5]); w.w = pk_bf16(a[6], a[7]);
                    *(u32x4*)(O + (size_t)r * DM + 512 + c) = w;
                }
            }
    }
};

template <class Epi> __device__ __forceinline__ void run_gemm(const Ctx& C, LAS unsigned char* lds, const bf16_t* A, const bf16_t* Bt, int M, int N, int K, const Epi& E) {
    pg8::Gemm g{A, Bt, M, N, K}; pg8::StaticOrder S; S.init(M, N, C.G, C.bid);
    if constexpr (Epi::NEED_RS) {
        LAS float* rst = (LAS float*)(lds + LDS_RS);
#pragma unroll 1
        for (int i = 0; i < 8; ++i) {
            pg8::Unit u; if (!S.next(i, u)) break;
            if (C.tid < 256) { const f32x4 sp = *(const f32x4*)(E.ss + (size_t)(u.pm * 256 + C.tid) * 4); rst[i * 256 + C.tid] = rsqrtf(((sp[0] + sp[1]) + (sp[2] + sp[3])) * (1.0f / 1024.0f) + EPS); }
        }
        __syncthreads();
    }
    pg8::gemm_phase<Epi, pg8::StaticOrder, false>(lds, g, S, E, nullptr);
    __syncthreads();
}

__device__ __forceinline__ void tr_tile(const Ctx& C, LAS float* tl, const float* __restrict__ src, int ld, int c0, int col0, int ncols, int k0, bf16_t* dst, int Kd, int r0, const float* __restrict__ gain, int mode) {
    const int tid = C.tid, cc = tid & 255, kq = tid >> 8;
    const bool ok = (col0 + cc) < ncols;
    const float* ps = src + (size_t)(k0 + kq) * ld + c0 + col0 + cc;
    float v[32];
#pragma unroll
    for (int i = 0; i < 32; ++i) v[i] = ok ? ps[(size_t)(2 * i) * ld] : 0.f;
    if (gain) {
#pragma unroll
        for (int i = 0; i < 32; ++i) v[i] *= gain[k0 + kq + 2 * i];
    }
#pragma unroll
    for (int i = 0; i < 32; ++i) tl[(kq + 2 * i) * 257 + cc] = v[i];
    __syncthreads();
    const int kc = (tid & 7) * 8;
#pragma unroll
    for (int pass = 0; pass < 4; ++pass) {
        const int rc = (tid >> 3) + pass * 64, col = col0 + rc;
        float o[8];
#pragma unroll
        for (int j = 0; j < 8; ++j) o[j] = tl[(kc + j) * 257 + rc];
        u32x4 w; w.x = pk_bf16(o[0], o[1]); w.y = pk_bf16(o[2], o[3]); w.z = pk_bf16(o[4], o[5]); w.w = pk_bf16(o[6], o[7]);
        const int row = r0 + (mode ? ((col >> 7) * 256 + (col & 127)) : col);
        if (col < ((ncols + 63) & ~63)) *(u32x4*)(dst + (size_t)row * Kd + k0 + kc) = w;
    }
    __syncthreads();
}
__device__ __forceinline__ void tr_job(const Ctx& C, LAS float* tl, int rot, const float* src, int ld, int c0, int ncols, int K, bf16_t* dst, int r0, const float* gain, int mode) {
    const int nct = (ncols + 255) >> 8, nkt = K >> 6, G = C.nw;
    int first = (C.wk - rot) % G; if (first < 0) first += G;
    for (int t = first; t < nct * nkt; t += G) {
        const int ct = t % nct, kt = t / nct;
        tr_tile(C, tl, src, ld, c0, ct * 256, ncols, kt * 64, dst, K, r0, gain, mode);
    }
}
__device__ __forceinline__ void phase_convert(const Ctx& P, int layer, LAS unsigned char* lds, int parts) {
    LAS float* tl = (LAS float*)lds;
    unsigned char* ws = P.ws; const int i = layer >> 1; const bool even = (layer & 1) == 0;
    const size_t wgu = (size_t)DM * FF;
    if (parts & 1) {
        tr_job(P, tl, 0, inp(2) + layer * wgu, FF, 0, FF, DM, (bf16_t*)(ws + OFF_GU1), 0, inp(1) + layer * DM, 1);
        tr_job(P, tl, 0, inp(3) + layer * wgu, FF, 0, FF, DM, (bf16_t*)(ws + OFF_GU1), 128, inp(1) + layer * DM, 1);
        tr_job(P, tl, 0, inp(4) + layer * wgu, DM, 0, DM, FF, (bf16_t*)(ws + OFF_D1), 0, nullptr, 0);
    }
    if (parts & 2) {
        tr_job(P, tl, 0, inp(32) + layer * wgu, FF, 0, FF, DM, (bf16_t*)(ws + OFF_GU2), 0, inp(31) + layer * DM, 1);
        tr_job(P, tl, 48, inp(33) + layer * wgu, FF, 0, FF, DM, (bf16_t*)(ws + OFF_GU2), 128, inp(31) + layer * DM, 1);
    }
    if (parts & 4) {
        tr_job(P, tl, 0, inp(34) + layer * wgu, DM, 0, DM, FF, (bf16_t*)(ws + OFF_D2), 0, nullptr, 0);
    }
    const float* mg = inp(5) + layer * DM;
    if (!(parts & 8)) {}
    else if (even) {
        const float* win = inp(6) + (size_t)i * DM * 2056;
        bf16_t* wt = (bf16_t*)(ws + OFF_WIN);
        tr_job(P, tl, 0, win, 2056, 0, 1536, DM, wt, 0, mg, 0);
        tr_job(P, tl, 128, win, 2056, 1544, 512, DM, wt, 1536, mg, 0);
        tr_job(P, tl, 0, win, 2056, 1536, 8, DM, wt, 2048, mg, 0);
        for (size_t e = (size_t)P.wk * 512 + P.tid; e < (size_t)192 * DM / 8; e += (size_t)P.nw * 512) ((u32x4*)(wt + (size_t)2112 * DM))[e] = (u32x4){0u, 0u, 0u, 0u};
        tr_job(P, tl, 16, inp(7) + (size_t)i * DM * DM, DM, 0, DM, DM, (bf16_t*)(ws + OFF_WOUT), 0, nullptr, 0);
        tr_job(P, tl, 32, inp(22) + (size_t)i * 512 * 512, 512, 0, 512, 512, (bf16_t*)(ws + OFF_WX), 0, nullptr, 0);
    } else {
        tr_job(P, tl, 0, inp(24) + (size_t)i * DM * 2048, 2048, 0, 2048, DM, (bf16_t*)(ws + OFF_WIN), 0, mg, 0);
        tr_job(P, tl, 0, inp(25) + (size_t)i * DM * DM, DM, 0, DM, DM, (bf16_t*)(ws + OFF_WOUT), 0, nullptr, 0);
        for (int gq = 0; gq < 4; ++gq)
            tr_job(P, tl, gq * 4, inp(29) + ((size_t)i * 4 + gq) * 128 * 128, 128, 0, 128, 128, (bf16_t*)(ws + OFF_WX) + gq * 128 * 128, 0, nullptr, 0);
    }
#ifdef ZERO_SCRATCH
    if (layer == 0) { u32x4* z = (u32x4*)(ws + WS_XB); const size_t nz = (WS_END - WS_XB) / 16; for (size_t e = (size_t)P.bid * 512 + P.tid; e < nz; e += (size_t)P.G * 512) z[e] = (u32x4){0u, 0u, 0u, 0u}; asm volatile("s_waitcnt vmcnt(0)" ::: "memory"); __syncthreads(); }
#endif
    if (layer == 0 && (parts & 16)) {
        const float* x = inp(0); bf16_t* xb = (bf16_t*)(ws + WS_XB); float* ss = (float*)(ws + WS_SS);
        const int lane = P.tid & 63, wv = P.tid >> 6;
        for (int r = P.bid * 8 + wv; r < T_TOK; r += P.G * 8) {
            float q = 0.f;
#pragma unroll
            for (int k = 0; k < 4; ++k) {
                const size_t o = (size_t)r * DM + k * 256 + lane * 4;
                const f32x4 v = *(const f32x4*)(x + o);
                u32x2 w; w.x = pk_bf16(v[0], v[1]); w.y = pk_bf16(v[2], v[3]); *(u32x2*)(xb + o) = w;
                const float r0 = bf_lo(w.x), r1 = bf_hi(w.x), r2 = bf_lo(w.y), r3 = bf_hi(w.y);
                q += (r0 * r0 + r1 * r1) + (r2 * r2 + r3 * r3);
            }
#pragma unroll
            for (int o = 32; o >= 1; o >>= 1) q += __shfl_xor(q, o);
            if (lane == 0) *(f32x4*)(ss + (size_t)r * 4) = (f32x4){q, 0.f, 0.f, 0.f};
        }
    }
}

#define XB_TMO      128
#define XB_XCNT(j)  (256  + 64 * (j))
#define XB_XSUB(j)  (1280 + 64 * (j))
#define XB_XGEN(j)  (2304 + 64 * (j))
#define XB_TOP      3328
#define XB_TOPGEN   3392
#define XCD_BAR_WORDS 3456
#define XB_SPIN_CAP (1u << 18)

__device__ __forceinline__ unsigned xb_ld(unsigned* p)              { return __hip_atomic_load(p, __ATOMIC_RELAXED, __HIP_MEMORY_SCOPE_AGENT); }
__device__ __forceinline__ unsigned xb_add(unsigned* p, unsigned v) { return __hip_atomic_fetch_add(p, v, __ATOMIC_RELAXED, __HIP_MEMORY_SCOPE_AGENT); }
__device__ __forceinline__ unsigned xb_xcc_id() { return (unsigned)__builtin_amdgcn_s_getreg((3 << 11) | 20) & 0xFu; }
#define XB_SPIN(cond, bar) do { unsigned _sp = 0; while (cond) { __builtin_amdgcn_s_sleep(1); \
    if ((++_sp & 255u) == 0u) { if (xb_ld(&(bar)[XB_TMO])) break; if (_sp > XB_SPIN_CAP) { atomicAdd(&(bar)[XB_TMO], 1u); break; } } } } while (0)

struct XcdBarrier {
    unsigned* bar; unsigned x;
    volatile LAS unsigned* st;
};

__device__ __forceinline__ XcdBarrier xcd_barrier_post(unsigned* bar, volatile LAS unsigned* st) {
    XcdBarrier b; b.bar = bar; b.x = xb_xcc_id(); b.st = st;
    if (threadIdx.x == 0) (void)xb_add(&bar[XB_XCNT(b.x)], 1u);
    return b;
}
__device__ __forceinline__ void xcd_barrier_complete(unsigned* bar, unsigned x, unsigned& nloc, unsigned& nx) {
    const unsigned G = gridDim.x * gridDim.y * gridDim.z;
    unsigned sum, cnt, mine, sp = 0u;
    for (;;) {
        sum = 0u; cnt = 0u; mine = 0u;
#pragma unroll
        for (unsigned j = 0; j < 16; ++j) { const unsigned c = xb_ld(&bar[XB_XCNT(j)]); sum += c; cnt += (c > 0u) ? 1u : 0u; mine = (j == x) ? c : mine; }
        if (sum == G) break;
        __builtin_amdgcn_s_sleep(1);
        if ((++sp & 255u) == 0u) { if (xb_ld(&bar[XB_TMO])) break; if (sp > XB_SPIN_CAP) { atomicAdd(&bar[XB_TMO], 1u); break; } }
    }
    nloc = mine > 0u ? mine : 1u; nx = cnt > 0u ? cnt : 1u;
}

__device__ __forceinline__ void xcd_barrier(const XcdBarrier& b) {
    asm volatile("s_waitcnt vmcnt(0)" ::: "memory");
    __syncthreads();
    if (threadIdx.x == 0) {
        unsigned* bar = b.bar;
        __builtin_amdgcn_s_waitcnt(0);
        unsigned nloc = b.st[0], nx = b.st[1];
        if (nloc == 0u) { xcd_barrier_complete(bar, b.x, nloc, nx); b.st[0] = nloc; b.st[1] = nx; }
        const unsigned old = xb_add(&bar[XB_XSUB(b.x)], 1u);
        const unsigned gen = old / nloc;
        if (old + 1u == (gen + 1u) * nloc) {
            __builtin_amdgcn_fence(__ATOMIC_RELEASE, "agent");
            asm volatile("s_waitcnt vmcnt(0)" ::: "memory");
            const unsigned og = xb_add(&bar[XB_TOP], 1u);
            const unsigned tg = og / nx;
            if (og + 1u == (tg + 1u) * nx) xb_add(&bar[XB_TOPGEN], 1u);
            else XB_SPIN(xb_ld(&bar[XB_TOPGEN]) == tg, bar);
            __builtin_amdgcn_fence(__ATOMIC_ACQUIRE, "agent");
            xb_add(&bar[XB_XGEN(b.x)], 1u);
            asm volatile("s_waitcnt vmcnt(0)" ::: "memory");
        } else {
            XB_SPIN(xb_ld(&bar[XB_XGEN(b.x)]) == gen, bar);
            __builtin_amdgcn_fence(__ATOMIC_ACQUIRE, "agent");
            asm volatile("s_waitcnt vmcnt(0)" ::: "memory");
        }
    }
    __syncthreads();
}
__device__ __forceinline__ unsigned short bf16_1(float v) { return (unsigned short)(pk_bf16(v, 0.f) & 0xffffu); }
__device__ __forceinline__ u32x4 pack8(const float (&v)[8]) { u32x4 w; w.x = pk_bf16(v[0], v[1]); w.y = pk_bf16(v[2], v[3]); w.z = pk_bf16(v[4], v[5]); w.w = pk_bf16(v[6], v[7]); return w; }
__device__ __forceinline__ u32x2 pack4(f32x4 v) { u32x2 w; w.x = pk_bf16(v[0], v[1]); w.y = pk_bf16(v[2], v[3]); return w; }
__device__ __forceinline__ bf16x8 lfrag(const LAS unsigned char* p) { return *(const LAS bf16x8*)p; }

__device__ __forceinline__ void phase_o1(const Ctx& C, int i, LAS unsigned char* lds) {
    const int tid = C.tid, lane = tid & 63, wid = tid >> 6, fr = lane & 15, q4 = lane >> 4;
    const bf16_t* __restrict__ proj = (const bf16_t*)(C.ws + WS_R1);
    bf16_t* qn = (bf16_t*)(C.ws + WS_U2); bf16_t* kn = qn + (size_t)T_TOK * 512; bf16_t* vt = kn + (size_t)T_TOK * 512;
    bf16_t* mixed = (bf16_t*)(C.ws + WS_MIXED);
    const bf16_t* wpt = (const bf16_t*)(C.ws + OFF_WX);
    const float* qg = inp(26) + i * 64; const float* kg = inp(27) + i * 64; const float* psc = inp(30) + i * 512;
    for (int bc = C.vb; bc < 256; bc += C.G) {
        const int t0 = bc * 64, b = bc >> 6, c = bc & 63;
        {
            const int sub = tid & 15;
            const f32x4 gq = *(const f32x4*)(qg + sub * 4), gk = *(const f32x4*)(kg + sub * 4);
#pragma unroll 8
            for (int pass = 0; pass < 32; ++pass) {
                const int idx = pass * 32 + (tid >> 4), l = idx >> 4, rem = idx & 15, qk = rem >> 3, h = rem & 7;
                const u32x2 vr = *(const u32x2*)(proj + (size_t)(t0 + l) * LDP_O + qk * 512 + h * 64 + sub * 4);
                const f32x4 v = (f32x4){bf_lo(vr.x), bf_hi(vr.x), bf_lo(vr.y), bf_hi(vr.y)};
                float s = (v[0] * v[0] + v[1] * v[1]) + (v[2] * v[2] + v[3] * v[3]);
                s += __shfl_xor(s, 1); s += __shfl_xor(s, 2); s += __shfl_xor(s, 4); s += __shfl_xor(s, 8);
                const float rs = rsqrtf(s * (1.0f / 64.0f) + EPS) * (qk ? 1.0f : 0.125f);
                const f32x4 gg = qk ? gk : gq;
                *(u32x2*)((qk ? kn : qn) + (size_t)(t0 + l) * 512 + h * 64 + sub * 4) = pack4(v * rs * gg);
            }
        }
        {
            const bf16_t* pv = proj + (size_t)t0 * LDP_O + 1024 + tid;
            bf16_t* dst = vt + ((size_t)(b * 512 + tid)) * SEQ + c * 64;
#pragma unroll 4
            for (int l0 = 0; l0 < 8; ++l0) {
                unsigned v[8];
#pragma unroll
                for (int j = 0; j < 8; ++j) v[j] = pv[(size_t)(l0 * 8 + j) * LDP_O];
                *(u32x4*)(dst + l0 * 8) = (u32x4){v[0] | (v[1] << 16), v[2] | (v[3] << 16), v[4] | (v[5] << 16), v[6] | (v[7] << 16)};
            }
        }
        {
            const int ch = tid, gg = ch >> 7, w = 2 << gg, pos0 = c * 64;
            const bf16_t* pu = proj + (size_t)t0 * LDP_O + 1536 + ch;
            float sum = 0.f;
            if (c > 0) for (int k = 1; k <= w; ++k) sum += bfv(pu[-(long)k * LDP_O]);
#pragma unroll 1
            for (int lb = 0; lb < 64; lb += 16) {
                float uv[16], ov[16];
#pragma unroll
                for (int k = 0; k < 16; ++k) { uv[k] = bfv(pu[(size_t)(lb + k) * LDP_O]); ov[k] = (pos0 + lb + k - w >= 0) ? bfv(pu[((long)(lb + k) - w) * LDP_O]) : 0.f; }
#pragma unroll
                for (int k = 0; k < 16; ++k) {
                    const int l = lb + k, pos = pos0 + l;
                    sum += uv[k]; sum -= ov[k];
                    const int cnt = min(pos + 1, w);
                    ((LAS unsigned short*)lds)[l * 520 + ch] = bf16_1(sum / (float)cnt - uv[k]);
                }
            }
        }
        __syncthreads();
        {
            const int gg = wid >> 1, oh = wid & 1;
            f32x4 acc[4][4];
#pragma unroll
            for (int a = 0; a < 4; ++a)
#pragma unroll
                for (int d = 0; d < 4; ++d) acc[a][d] = (f32x4){0.f, 0.f, 0.f, 0.f};
#pragma unroll
            for (int ks = 0; ks < 4; ++ks) {
                bf16x8 wf[4], pf[4];
#pragma unroll
                for (int ot = 0; ot < 4; ++ot) wf[ot] = *(const bf16x8*)(wpt + ((size_t)(gg * 128 + oh * 64 + ot * 16 + fr)) * 128 + ks * 32 + q4 * 8);
#pragma unroll
                for (int lt = 0; lt < 4; ++lt) pf[lt] = lfrag(lds + ((lt * 16 + fr) * 520 + gg * 128 + ks * 32 + q4 * 8) * 2);
#pragma unroll
                for (int ot = 0; ot < 4; ++ot)
#pragma unroll
                    for (int lt = 0; lt < 4; ++lt) acc[ot][lt] = mfma16(wf[ot], pf[lt], acc[ot][lt]);
            }
#pragma unroll
            for (int ot = 0; ot < 4; ++ot) {
                const int o = oh * 64 + ot * 16 + q4 * 4;
                const f32x4 sc = *(const f32x4*)(psc + gg * 128 + o);
#pragma unroll
                for (int lt = 0; lt < 4; ++lt) *(u32x2*)(mixed + (size_t)(t0 + lt * 16 + fr) * DM + 512 + gg * 128 + o) = pack4(acc[ot][lt] * sc);
            }
        }
        __syncthreads();
    }
}

__device__ __forceinline__ void phase_o2(const Ctx& C, int i, LAS unsigned char* lds) {
    const int tid = C.tid, lane = tid & 63, wid = tid >> 6, fr = lane & 15, q4 = lane >> 4;
    LAS float* bias_s = (LAS float*)lds;
    { const float* rb = inp(28) + (size_t)i * 8 * 257; for (int e = tid; e < 8 * 257; e += 512) bias_s[e] = rb[e]; }
    __syncthreads();
    const bf16_t* __restrict__ qn = (const bf16_t*)(C.ws + WS_U2); const bf16_t* __restrict__ kn = qn + (size_t)T_TOK * 512; const bf16_t* __restrict__ vt = kn + (size_t)T_TOK * 512;
    bf16_t* mixed = (bf16_t*)(C.ws + WS_MIXED);
    const int NW = C.G * 8;
    for (int id = C.vb * 8 + wid; id < 4096; id += NW) {
        const int h = id & 7, qh = (id >> 3) & 1, bc = id >> 4, b = bc >> 6, c = bc & 63, t0 = bc * 64;
        bf16x8 qf[2][2];
#pragma unroll
        for (int qt = 0; qt < 2; ++qt)
#pragma unroll
            for (int ks = 0; ks < 2; ++ks) qf[qt][ks] = *(const bf16x8*)(qn + (size_t)(t0 + qh * 32 + qt * 16 + fr) * 512 + h * 64 + ks * 32 + q4 * 8);
        f32x4 o[4][2];
#pragma unroll
        for (int a = 0; a < 4; ++a) { o[a][0] = (f32x4){0.f, 0.f, 0.f, 0.f}; o[a][1] = (f32x4){0.f, 0.f, 0.f, 0.f}; }
        float mrun[2] = {-1e30f, -1e30f}, lsum[2] = {0.f, 0.f};
        const LAS float* bh = bias_s + h * 257;
        for (int kc = max(0, 8 - c); kc <= 8; ++kc) {
            const int kch = c - 8 + kc; const size_t s0 = (size_t)b * SEQ + kch * 64;
            f32x4 s[4][2];
#pragma unroll
            for (int kt = 0; kt < 4; ++kt) {
                const bf16_t* pk = kn + (s0 + kt * 16 + fr) * 512 + h * 64 + q4 * 8;
                const bf16x8 kf0 = *(const bf16x8*)pk, kf1 = *(const bf16x8*)(pk + 32);
#pragma unroll
                for (int qt = 0; qt < 2; ++qt) s[kt][qt] = mfma16(kf1, qf[qt][1], mfma16(kf0, qf[qt][0], (f32x4){0.f, 0.f, 0.f, 0.f}));
            }
            bf16x8 vfr[2][4];
#pragma unroll
            for (int kk = 0; kk < 2; ++kk)
#pragma unroll
                for (int dt = 0; dt < 4; ++dt) {
                    const bf16_t* pv = vt + ((size_t)(b * 512 + h * 64 + dt * 16 + fr)) * SEQ + kch * 64 + kk * 32 + q4 * 4;
                    const u32x2 lo = *(const u32x2*)pv, hi = *(const u32x2*)(pv + 16);
                    vfr[kk][dt] = as_bf16x8((u32x4){lo.x, lo.y, hi.x, hi.y});
                }
            const int dbase = (8 - kc) * 64;
#pragma unroll
            for (int qt = 0; qt < 2; ++qt) {
                const int lq = qh * 32 + qt * 16 + fr; float mx = -1e30f;
#pragma unroll
                for (int kt = 0; kt < 4; ++kt)
#pragma unroll
                    for (int r = 0; r < 4; ++r) {
                        int dist = dbase + lq - (kt * 16 + q4 * 4 + r); dist = min(max(dist, -128), 128) + 128;
                        const float v = s[kt][qt][r] + bh[dist]; s[kt][qt][r] = v; mx = fmaxf(mx, v);
                    }
                mx = fmaxf(mx, __shfl_xor(mx, 16)); mx = fmaxf(mx, __shfl_xor(mx, 32));
                const float mnew = fmaxf(mrun[qt], mx), alpha = __expf(mrun[qt] - mnew); mrun[qt] = mnew;
                float ps = 0.f;
#pragma unroll
                for (int kt = 0; kt < 4; ++kt)
#pragma unroll
                    for (int r = 0; r < 4; ++r) { const float p = __expf(s[kt][qt][r] - mnew); s[kt][qt][r] = p; ps += p; }
                lsum[qt] = lsum[qt] * alpha + ps;
#pragma unroll
                for (int dt = 0; dt < 4; ++dt) o[dt][qt] *= alpha;
            }
#pragma unroll
            for (int kk = 0; kk < 2; ++kk) {
                bf16x8 pf[2];
#pragma unroll
                for (int qt = 0; qt < 2; ++qt) {
                    u32x4 w; w.x = pk_bf16(s[2 * kk][qt][0], s[2 * kk][qt][1]); w.y = pk_bf16(s[2 * kk][qt][2], s[2 * kk][qt][3]);
                    w.z = pk_bf16(s[2 * kk + 1][qt][0], s[2 * kk + 1][qt][1]); w.w = pk_bf16(s[2 * kk + 1][qt][2], s[2 * kk + 1][qt][3]);
                    pf[qt] = as_bf16x8(w);
                }
#pragma unroll
                for (int dt = 0; dt < 4; ++dt) {
                    const bf16x8 vf = vfr[kk][dt];
#pragma unroll
                    for (int qt = 0; qt < 2; ++qt) o[dt][qt] = mfma16(vf, pf[qt], o[dt][qt]);
                }
            }
        }
#pragma unroll
        for (int qt = 0; qt < 2; ++qt) {
            float ls = lsum[qt]; ls += __shfl_xor(ls, 16); ls += __shfl_xor(ls, 32);
            const float inv = 1.0f / ls; const int lq = qh * 32 + qt * 16 + fr;
#pragma unroll
            for (int dt = 0; dt < 4; ++dt) *(u32x2*)(mixed + (size_t)(t0 + lq) * DM + h * 64 + dt * 16 + q4 * 4) = pack4(o[dt][qt] * inv);
        }
    }
    __syncthreads();
}
constexpr int L_XST = 0, L_BM = 36864, L_CM = 54272, L_BMT = 71680, L_GS = 90112, L_DTS = 126976, L_ACS = 128000;

__device__ __forceinline__ void ssd_stage(const Ctx& C, int i, LAS unsigned char* lds, int bc, int g) {
    const int tid = C.tid, lane = tid & 63, wid = tid >> 6, c = bc & 63;
    const bf16_t* __restrict__ proj = (const bf16_t*)(C.ws + WS_R1);
    const int t0 = bc * 64;
    int cx; if (tid < 256) cx = g * 256 + tid; else if (tid < 384) cx = 512 + g * 128 + (tid - 256); else cx = 768 + g * 128 + (tid - 384);
    const float* cw = inp(8) + (size_t)i * 4096; const float cb = inp(9)[i * 1024 + cx];
    const float w0 = cw[cx], w1 = cw[1024 + cx], w2 = cw[2048 + cx], w3 = cw[3072 + cx];
    const bf16_t* px = proj + (size_t)t0 * LDP_E + 512 + cx;
    float xm3 = 0.f, xm2 = 0.f, xm1 = 0.f;
    if (c > 0) { xm3 = bfv(px[-3 * LDP_E]); xm2 = bfv(px[-2 * LDP_E]); xm1 = bfv(px[-LDP_E]); }
#pragma unroll 4
    for (int l0 = 0; l0 < 8; ++l0) {
        float sv[8];
#pragma unroll
        for (int j = 0; j < 8; ++j) { const float xv = bfv(px[(size_t)(l0 * 8 + j) * LDP_E]); const float v = cb + w0 * xm3 + w1 * xm2 + w2 * xm1 + w3 * xv; sv[j] = silu_f(v); xm3 = xm2; xm2 = xm1; xm1 = xv; }
        const u32x4 w = pack8(sv);
        if (tid < 256) *(LAS u32x4*)(lds + L_XST + tid * 144 + l0 * 16) = w;
        else if (tid < 384) {
            const int n = tid - 256; *(LAS u32x4*)(lds + L_BMT + n * 144 + l0 * 16) = w;
            LAS unsigned short* d = (LAS unsigned short*)(lds + L_BM) + (l0 * 8) * 136 + n;
            d[0] = (unsigned short)(w.x & 0xffffu); d[136] = (unsigned short)(w.x >> 16); d[2 * 136] = (unsigned short)(w.y & 0xffffu); d[3 * 136] = (unsigned short)(w.y >> 16);
            d[4 * 136] = (unsigned short)(w.z & 0xffffu); d[5 * 136] = (unsigned short)(w.z >> 16); d[6 * 136] = (unsigned short)(w.w & 0xffffu); d[7 * 136] = (unsigned short)(w.w >> 16);
        } else {
            const int n = tid - 384;
            LAS unsigned short* d = (LAS unsigned short*)(lds + L_CM) + (l0 * 8) * 136 + n;
            d[0] = (unsigned short)(w.x & 0xffffu); d[136] = (unsigned short)(w.x >> 16); d[2 * 136] = (unsigned short)(w.y & 0xffffu); d[3 * 136] = (unsigned short)(w.y >> 16);
            d[4 * 136] = (unsigned short)(w.z & 0xffffu); d[5 * 136] = (unsigned short)(w.z >> 16); d[6 * 136] = (unsigned short)(w.w & 0xffffu); d[7 * 136] = (unsigned short)(w.w >> 16);
        }
    }
    if (wid < 4) {
        const int hh = g * 4 + wid;
        const float xx = ((const float*)(C.ws + WS_DTR))[(size_t)(t0 + lane) * 8 + hh] + inp(10)[i * 8 + hh];
        const float dtv = xx > 20.f ? xx : log1pf(expf(xx));
        float v = -expf(inp(11)[i * 8 + hh]) * dtv;
#pragma unroll
        for (int off = 1; off < 64; off <<= 1) { const float t = __shfl_up(v, off); if (lane >= off) v += t; }
        ((LAS float*)(lds + L_DTS))[lane * 4 + wid] = dtv; ((LAS float*)(lds + L_ACS))[lane * 4 + wid] = v;
    }
    __syncthreads();
}

__device__ __forceinline__ void ssd_states(const Ctx& C, int i, LAS unsigned char* lds) {
    const int tid = C.tid, lane = tid & 63, wid = tid >> 6, fr = lane & 15, q4 = lane >> 4;
    float* states = (float*)(C.ws + WS_U2); float* cdec = (float*)(C.ws + WS_CDEC);
    const LAS float* DTS = (const LAS float*)(lds + L_DTS); const LAS float* ACS = (const LAS float*)(lds + L_ACS);
    LAS float* WTS = (LAS float*)(lds + L_GS);
    for (int u = C.vb; u < 512; u += C.G) {
        const int g = u & 1, bc = u >> 1;
        ssd_stage(C, i, lds, bc, g);
        if (tid < 256) WTS[tid] = DTS[tid] * expf(ACS[63 * 4 + (tid & 3)] - ACS[tid]);
        if (tid < 4) cdec[bc * 8 + g * 4 + tid] = expf(ACS[63 * 4 + tid]);
        __syncthreads();
        const int j = wid >> 1, nh = wid & 1;
        f32x4 acc[4][4];
#pragma unroll
        for (int a = 0; a < 4; ++a)
#pragma unroll
            for (int d = 0; d < 4; ++d) acc[a][d] = (f32x4){0.f, 0.f, 0.f, 0.f};
#pragma unroll
        for (int ks = 0; ks < 2; ++ks) {
            float wv[8];
#pragma unroll
            for (int e = 0; e < 8; ++e) wv[e] = WTS[(ks * 32 + q4 * 8 + e) * 4 + j];
            bf16x8 af[4];
#pragma unroll
            for (int pt = 0; pt < 4; ++pt) {
                const u32x4 raw = *(const LAS u32x4*)(lds + L_XST + (j * 64 + pt * 16 + fr) * 144 + (ks * 32 + q4 * 8) * 2);
                u32x4 w; w.x = pk_bf16(bf_lo(raw.x) * wv[0], bf_hi(raw.x) * wv[1]); w.y = pk_bf16(bf_lo(raw.y) * wv[2], bf_hi(raw.y) * wv[3]);
                w.z = pk_bf16(bf_lo(raw.z) * wv[4], bf_hi(raw.z) * wv[5]); w.w = pk_bf16(bf_lo(raw.w) * wv[6], bf_hi(raw.w) * wv[7]);
                af[pt] = as_bf16x8(w);
            }
#pragma unroll
            for (int nt = 0; nt < 4; ++nt) {
                const bf16x8 bfr = lfrag(lds + L_BMT + (nh * 64 + nt * 16 + fr) * 144 + (ks * 32 + q4 * 8) * 2);
#pragma unroll
                for (int pt = 0; pt < 4; ++pt) acc[pt][nt] = mfma16(bfr, af[pt], acc[pt][nt]);
            }
        }
        float* st = states + ((size_t)(bc * 8 + g * 4 + j)) * 8192;
#pragma unroll
        for (int pt = 0; pt < 4; ++pt)
#pragma unroll
            for (int nt = 0; nt < 4; ++nt) *(f32x4*)(st + (pt * 16 + fr) * 128 + nh * 64 + nt * 16 + q4 * 4) = acc[pt][nt];
        __syncthreads();
    }
}

__device__ __forceinline__ void ssd_output(const Ctx& C, int i, LAS unsigned char* lds) {
    const int tid = C.tid, lane = tid & 63, wid = tid >> 6, fr = lane & 15, q4 = lane >> 4;
    const bf16_t* __restrict__ proj = (const bf16_t*)(C.ws + WS_R1);
    const bf16_t* __restrict__ hbf = (const bf16_t*)(C.ws + WS_HBF);
    bf16_t* mixed = (bf16_t*)(C.ws + WS_MIXED);
    const LAS float* DTS = (const LAS float*)(lds + L_DTS); const LAS float* ACS = (const LAS float*)(lds + L_ACS);
    LAS float* RED = (LAS float*)(lds + L_BMT);
    for (int u = C.vb; u < 512; u += C.G) {
        const int g = u & 1, bc = u >> 1, t0 = bc * 64;
        ssd_stage(C, i, lds, bc, g);
        {
            const int lt = wid >> 1;
            float dsk[4];
#pragma unroll
            for (int j = 0; j < 4; ++j) dsk[j] = inp(12)[i * 8 + g * 4 + j];
#pragma unroll
            for (int s2 = 0; s2 < 2; ++s2) {
                const int st = (wid & 1) * 2 + s2;
                f32x4 cb = (f32x4){0.f, 0.f, 0.f, 0.f};
#pragma unroll
                for (int ks = 0; ks < 4; ++ks)
                    cb = mfma16(lfrag(lds + L_CM + (lt * 16 + fr) * 272 + (ks * 32 + q4 * 8) * 2), lfrag(lds + L_BM + (st * 16 + fr) * 272 + (ks * 32 + q4 * 8) * 2), cb);
                const int s = st * 16 + fr;
#pragma unroll
                for (int j = 0; j < 4; ++j) {
                    const float as = ACS[s * 4 + j], dts = DTS[s * 4 + j];
#pragma unroll
                    for (int r = 0; r < 4; ++r) {
                        const int l = lt * 16 + q4 * 4 + r; float gv = 0.f;
                        if (s <= l) gv = cb[r] * __expf(ACS[l * 4 + j] - as) * dts;
                        if (s == l) gv += dsk[j];
                        ((LAS unsigned short*)(lds + L_GS))[(j * 64 + l) * 72 + s] = bf16_1(gv);
                    }
                }
            }
        }
        __syncthreads();
        const int j = wid >> 1, ph = wid & 1, hh = g * 4 + j;
        f32x4 a1[4][2], a2[4][2];
#pragma unroll
        for (int a = 0; a < 4; ++a) { a1[a][0] = (f32x4){0.f, 0.f, 0.f, 0.f}; a1[a][1] = a1[a][0]; a2[a][0] = a1[a][0]; a2[a][1] = a1[a][0]; }
#pragma unroll
        for (int ks = 0; ks < 2; ++ks) {
            bf16x8 xf[2], gf[4];
#pragma unroll
            for (int pt = 0; pt < 2; ++pt) xf[pt] = lfrag(lds + L_XST + (j * 64 + ph * 32 + pt * 16 + fr) * 144 + (ks * 32 + q4 * 8) * 2);
#pragma unroll
            for (int lt = 0; lt < 4; ++lt) gf[lt] = lfrag(lds + L_GS + (j * 64 + lt * 16 + fr) * 144 + (ks * 32 + q4 * 8) * 2);
#pragma unroll
            for (int lt = 0; lt < 4; ++lt)
#pragma unroll
                for (int pt = 0; pt < 2; ++pt) a1[lt][pt] = mfma16(xf[pt], gf[lt], a1[lt][pt]);
        }
        const bf16_t* hb = hbf + ((size_t)(bc * 8 + hh)) * 8192;
#pragma unroll
        for (int ks = 0; ks < 4; ++ks) {
            bf16x8 hf[2], cf[4];
#pragma unroll
            for (int pt = 0; pt < 2; ++pt) hf[pt] = *(const bf16x8*)(hb + (ph * 32 + pt * 16 + fr) * 128 + ks * 32 + q4 * 8);
#pragma unroll
            for (int lt = 0; lt < 4; ++lt) cf[lt] = lfrag(lds + L_CM + (lt * 16 + fr) * 272 + (ks * 32 + q4 * 8) * 2);
#pragma unroll
            for (int lt = 0; lt < 4; ++lt)
#pragma unroll
                for (int pt = 0; pt < 2; ++pt) a2[lt][pt] = mfma16(hf[pt], cf[lt], a2[lt][pt]);
        }
#pragma unroll
        for (int lt = 0; lt < 4; ++lt) {
            const int l = lt * 16 + fr; const float ea = __expf(ACS[l * 4 + j]); float q = 0.f;
#pragma unroll
            for (int pt = 0; pt < 2; ++pt) {
                const u32x2 zr = *(const u32x2*)(proj + (size_t)(t0 + l) * LDP_E + hh * 64 + ph * 32 + pt * 16 + q4 * 4);
                const f32x4 zv = (f32x4){bf_lo(zr.x), bf_hi(zr.x), bf_lo(zr.y), bf_hi(zr.y)};
#pragma unroll
                for (int r = 0; r < 4; ++r) { float v = a1[lt][pt][r] + ea * a2[lt][pt][r]; v *= silu_f(zv[r]); a1[lt][pt][r] = v; q += v * v; }
            }
            q += __shfl_xor(q, 16); q += __shfl_xor(q, 32);
            if (q4 == 0) RED[wid * 64 + l] = q;
        }
        __syncthreads();
#pragma unroll
        for (int lt = 0; lt < 4; ++lt) {
            const int l = lt * 16 + fr; float q = 0.f;
#pragma unroll
            for (int w = 0; w < 8; ++w) q += RED[w * 64 + l];
            const float rs = rsqrtf(q * (1.0f / 256.0f) + EPS);
#pragma unroll
            for (int pt = 0; pt < 2; ++pt) {
                const int ch = hh * 64 + ph * 32 + pt * 16 + q4 * 4;
                const f32x4 gn = *(const f32x4*)(inp(13) + i * 512 + ch);
                *(u32x2*)(mixed + (size_t)(t0 + l) * DM + ch) = pack4(a1[lt][pt] * rs * gn);
            }
        }
        __syncthreads();
    }
}

__device__ __forceinline__ void s5_disc(int i, int g, int p, float& abr, float& abi, float& fre, float& fim) {
    const float ar = inp(14)[(i * 32 + g) * 64 + p], ai = inp(15)[(i * 32 + g) * 64 + p];
    const float dt = expf(inp(16)[i * 32 + g]);
    const float em1 = expm1f(dt * ar), th = dt * ai, sn = sinf(th), cs = cosf(th), sh = sinf(0.5f * th);
    const float m1r = em1 * cs - 2.0f * sh * sh;
    abr = 1.0f + m1r; abi = (1.0f + em1) * sn;
    const float den = ar * ar + ai * ai;
    fre = (m1r * ar + abi * ai) / den; fim = (abi * ar - m1r * ai) / den;
}

__device__ __forceinline__ void s5_pass(const Ctx& C, int i, LAS unsigned char* lds, const int mode) {
    const int tid = C.tid, lane = tid & 63, wid = tid >> 6, fr = lane & 15, q4 = lane >> 4;
    const bf16_t* __restrict__ proj = (const bf16_t*)(C.ws + WS_R1);
    f32x2* s5e = (f32x2*)(C.ws + WS_S5E);
    float* ys = (float*)(C.ws + WS_U2); bf16_t* gy = (bf16_t*)(C.ws + WS_U2 + 33554432);
    LAS float* drv = (LAS float*)(lds + wid * 12544);
    LAS unsigned char* drvb = lds + wid * 12544;
    LAS unsigned char* hc = lds + wid * 12544 + 8192;
    const int NW = C.G * 8;
    const bf16x8 zf = as_bf16x8((u32x4){0u, 0u, 0u, 0u});
    int gprev = -1;
    float abr = 0.f, abi = 0.f; bf16x8 bbf[8], cmf[4]; f32x4 dsk = (f32x4){0.f, 0.f, 0.f, 0.f};
#pragma unroll
    for (int e = 0; e < 8; ++e) bbf[e] = zf;
#pragma unroll
    for (int e = 0; e < 4; ++e) cmf[e] = zf;
    for (int unit = C.vb * 8 + wid; unit < 8192; unit += NW) {
        const int g = unit & 31, bc = unit >> 5, t0 = bc * 64;
        if (g != gprev) {
            gprev = g;
            float fre, fim; s5_disc(i, g, lane, abr, abi, fre, fim);
            const float* pbr = inp(17) + ((size_t)(i * 32 + g) * 64 + lane) * 16; const float* pbi = inp(18) + ((size_t)(i * 32 + g) * 64 + lane) * 16;
            float re[16], im[16];
#pragma unroll
            for (int k = 0; k < 4; ++k) {
                const f32x4 br = *(const f32x4*)(pbr + k * 4), bi = *(const f32x4*)(pbi + k * 4);
#pragma unroll
                for (int e = 0; e < 4; ++e) { re[k * 4 + e] = fre * br[e] - fim * bi[e]; im[k * 4 + e] = fre * bi[e] + fim * br[e]; }
            }
            u32x4 w;
            w.x = pk_bf16(re[0], re[1]); w.y = pk_bf16(re[2], re[3]); w.z = pk_bf16(re[4], re[5]); w.w = pk_bf16(re[6], re[7]); *(LAS u32x4*)(drvb + lane * 32) = w;
            w.x = pk_bf16(re[8], re[9]); w.y = pk_bf16(re[10], re[11]); w.z = pk_bf16(re[12], re[13]); w.w = pk_bf16(re[14], re[15]); *(LAS u32x4*)(drvb + lane * 32 + 16) = w;
            w.x = pk_bf16(im[0], im[1]); w.y = pk_bf16(im[2], im[3]); w.z = pk_bf16(im[4], im[5]); w.w = pk_bf16(im[6], im[7]); *(LAS u32x4*)(drvb + (64 + lane) * 32) = w;
            w.x = pk_bf16(im[8], im[9]); w.y = pk_bf16(im[10], im[11]); w.z = pk_bf16(im[12], im[13]); w.w = pk_bf16(im[14], im[15]); *(LAS u32x4*)(drvb + (64 + lane) * 32 + 16) = w;
#pragma unroll
            for (int pt = 0; pt < 8; ++pt) { const bf16x8 f = lfrag(drvb + (pt * 16 + fr) * 32 + (q4 & 1) * 16); bbf[pt] = (q4 < 2) ? f : zf; }
            if (mode) {
                const float* pcr = inp(19) + ((size_t)(i * 32 + g) * 16 + fr) * 64 + q4 * 8; const float* pci = inp(20) + ((size_t)(i * 32 + g) * 16 + fr) * 64 + q4 * 8;
#pragma unroll
                for (int ks = 0; ks < 2; ++ks) {
                    const f32x4 a = *(const f32x4*)(pcr + ks * 32), b2 = *(const f32x4*)(pcr + ks * 32 + 4), cc = *(const f32x4*)(pci + ks * 32), d2 = *(const f32x4*)(pci + ks * 32 + 4);
                    u32x4 x; x.x = pk_bf16(a[0], a[1]); x.y = pk_bf16(a[2], a[3]); x.z = pk_bf16(b2[0], b2[1]); x.w = pk_bf16(b2[2], b2[3]); cmf[ks] = as_bf16x8(x);
                    u32x4 v; v.x = pk_bf16(-cc[0], -cc[1]); v.y = pk_bf16(-cc[2], -cc[3]); v.z = pk_bf16(-d2[0], -d2[1]); v.w = pk_bf16(-d2[2], -d2[3]); cmf[2 + ks] = as_bf16x8(v);
                }
                dsk = *(const f32x4*)(inp(21) + (size_t)(i * 32 + g) * 16 + q4 * 4);
            }
        }
        bf16x8 uf[4]; f32x4 uu[4];
#pragma unroll
        for (int tb = 0; tb < 4; ++tb) {
            const bf16_t* pu = proj + (size_t)(t0 + tb * 16 + fr) * LDP_E + 1536 + g * 16;
            const bf16x8 x = *(const bf16x8*)(pu + (q4 & 1) * 8);
            uf[tb] = (q4 < 2) ? x : zf;
            const u32x2 ur = *(const u32x2*)(pu + q4 * 4);
            uu[tb] = (f32x4){bf_lo(ur.x), bf_hi(ur.x), bf_lo(ur.y), bf_hi(ur.y)};
        }
        float hr = 0.f, hi = 0.f;
        if (mode) { const f32x2 h0 = s5e[(size_t)(bc * 32 + g) * 64 + lane]; hr = h0.x; hi = h0.y; }
#pragma unroll
        for (int tb = 0; tb < 4; ++tb) {
#pragma unroll
            for (int pt = 0; pt < 8; ++pt) {
                const f32x4 d = mfma16(uf[tb], bbf[pt], (f32x4){0.f, 0.f, 0.f, 0.f});
#pragma unroll
                for (int r = 0; r < 4; ++r) drv[(q4 * 4 + r) * 128 + pt * 16 + fr] = d[r];
            }
#pragma unroll
            for (int tt = 0; tt < 16; ++tt) {
                const float dr = drv[tt * 128 + lane], di = drv[tt * 128 + 64 + lane];
                const float nr = abr * hr - abi * hi + dr, ni = abr * hi + abi * hr + di; hr = nr; hi = ni;
                if (mode) { ((LAS unsigned short*)hc)[tt * 136 + lane] = bf16_1(hr); ((LAS unsigned short*)hc)[tt * 136 + 64 + lane] = bf16_1(hi); }
            }
            if (mode) {
                f32x4 acc = (f32x4){0.f, 0.f, 0.f, 0.f};
#pragma unroll
                for (int ks = 0; ks < 4; ++ks) acc = mfma16(cmf[ks], lfrag(hc + (fr * 136 + ks * 32 + q4 * 8) * 2), acc);
                const int t = tb * 16 + fr;
                const f32x4 y = acc + dsk * uu[tb];
                const size_t o = (size_t)(t0 + t) * 512 + g * 16 + q4 * 4;
                *(f32x4*)(ys + o) = y;
                f32x4 ge;
#pragma unroll
                for (int r = 0; r < 4; ++r) { const float z = 0.7978845608f * (y[r] + 0.044715f * y[r] * y[r] * y[r]); ge[r] = 0.5f * y[r] * (2.0f - 2.0f * __builtin_amdgcn_rcpf(1.0f + __expf(2.0f * z))); }
                *(u32x2*)(gy + o) = pack4(ge);
            }
        }
        if (!mode) s5e[(size_t)(bc * 32 + g) * 64 + lane] = (f32x2){hr, hi};
    }
}

__device__ __forceinline__ void phase_e1(const Ctx& C, int i, LAS unsigned char* lds) { ssd_states(C, i, lds); s5_pass(C, i, lds, 0); __syncthreads(); }
__device__ __forceinline__ void phase_e3(const Ctx& C, int i, LAS unsigned char* lds) { ssd_output(C, i, lds); s5_pass(C, i, lds, 1); __syncthreads(); }

__device__ __forceinline__ void phase_e2(const Ctx& C, int i, bool do_s5 = true) {
    const float* __restrict__ states = (const float*)(C.ws + WS_U2); const float* __restrict__ cdec = (const float*)(C.ws + WS_CDEC);
    bf16_t* __restrict__ hbf = (bf16_t*)(C.ws + WS_HBF);
    for (int idx = C.bid * 512 + C.tid; idx < 131072; idx += C.G * 512) {
        const int n2 = idx & 63, p = (idx >> 6) & 63, h = (idx >> 12) & 7, b = idx >> 15;
        f32x2 run = (f32x2){0.f, 0.f};
#pragma unroll 8
        for (int c = 0; c < 64; ++c) {
            const size_t un = (size_t)((b * 64 + c) * 8 + h), o = un * 8192 + p * 128 + n2 * 2;
            const f32x2 s = *(const f32x2*)(states + o); const float d = cdec[un];
            *(unsigned*)(hbf + o) = pk_bf16(run.x, run.y);
            run = run * d + s;
        }
    }
    f32x2* s5e = (f32x2*)(C.ws + WS_S5E);
    if (do_s5)
    for (int idx = C.bid * 512 + C.tid; idx < 8192; idx += C.G * 512) {
        const int p = idx & 63, g = (idx >> 6) & 31, b = idx >> 11;
        float ar, ai, fre, fim; s5_disc(i, g, p, ar, ai, fre, fim);
#pragma unroll
        for (int k = 0; k < 6; ++k) { const float nr = ar * ar - ai * ai, ni = 2.0f * ar * ai; ar = nr; ai = ni; }
        float hr = 0.f, hi = 0.f;
        f32x2* e0 = s5e + (size_t)(b * 64 * 32 + g) * 64 + p;
#pragma unroll 1
        for (int c0 = 0; c0 < 64; c0 += 16) {
            f32x2 s[16];
#pragma unroll
            for (int k = 0; k < 16; ++k) s[k] = e0[(size_t)(c0 + k) * 2048];
#pragma unroll
            for (int k = 0; k < 16; ++k) {
                e0[(size_t)(c0 + k) * 2048] = (f32x2){hr, hi};
                const float nr = ar * hr - ai * hi + s[k].x, ni = ar * hi + ai * hr + s[k].y; hr = nr; hi = ni;
            }
        }
    }
}
enum { OP_CONV = 0, OP_GU, OP_DOWN, OP_IN, OP_E1, OP_E2, OP_E3, OP_GLU, OP_O1, OP_O2, OP_OUT };
constexpr int N_PHASES = 40;

__global__ void __launch_bounds__(512, 2) fwd_kernel(Params P) {
    extern __shared__ __attribute__((aligned(16))) unsigned char lds_raw[];
    LAS unsigned char* lds = (LAS unsigned char*)lds_raw;
    cg::grid_group grid = cg::this_grid();
    if (threadIdx.x < 4) ((LAS unsigned*)(lds + 131072))[threadIdx.x] = 0u;
    __syncthreads();
    const XcdBarrier xbar = xcd_barrier_post((unsigned*)(P.ws + WS_BAR), (volatile LAS unsigned*)(lds + 131072));
    unsigned char* ws = P.ws;
    float* ssb = (float*)(ws + WS_SS);
    bf16_t* xb = (bf16_t*)(ws + WS_XB);
    bf16_t* mixed = (bf16_t*)(ws + WS_MIXED);
#ifdef REP_MASK
    for (int pp = 2 * P.ph_lo; pp < 2 * P.ph_hi; ++pp) {
        const int ph = pp >> 1, rep = pp & 1;
#else
    for (int ph = P.ph_lo; ph < P.ph_hi; ++ph) {
#endif
        Ctx C; { int t_ = threadIdx.x, b_ = blockIdx.x, g_ = gridDim.x; asm volatile("" : "+v"(t_), "+s"(b_), "+s"(g_)); unsigned char* w_ = P.ws; float* o_ = P.out; asm volatile("" : "+s"(w_), "+s"(o_)); C.out = o_; C.ws = w_; C.tid = t_; C.bid = b_; C.G = g_; C.wk = b_; C.nw = g_; C.vb = (g_ & 7) == 0 ? (b_ & 7) * (g_ >> 3) + (b_ >> 3) : b_; }
        int layer, sub;
        if (ph < 11) { layer = 0; sub = ph; } else if (ph < 20) { layer = 1; sub = ph - 11; } else if (ph < 31) { layer = 2; sub = ph - 20; } else { layer = 3; sub = ph - 31; }
        const bool even = (layer & 1) == 0; const int i = layer >> 1;
        int op, which = 0;
        if (sub <= 3) { op = sub == 0 ? OP_CONV : sub == 1 ? OP_GU : sub == 2 ? OP_DOWN : OP_IN; }
        else if (even) { op = sub == 4 ? OP_E1 : sub == 5 ? OP_E2 : sub == 6 ? OP_E3 : sub == 7 ? OP_GLU : sub == 8 ? OP_OUT : sub == 9 ? OP_GU : OP_DOWN; which = sub >= 9; }
        else { op = sub == 4 ? OP_O1 : sub == 5 ? OP_O2 : sub == 6 ? OP_OUT : sub == 7 ? OP_GU : OP_DOWN; which = sub >= 7; }
#ifdef REP_MASK
        const bool masked = ((REP_MASK >> op) & 1) != 0;
        if (rep == 1 && !masked) continue;
#endif
        if (op == OP_CONV && layer > 0 && C.G == 256) continue;
        switch (op) {
        case OP_CONV: phase_convert(C, layer, lds, (C.G == 256) ? (1 | 8 | 16) : 31); break;
        case OP_GU: {
            EpiGateUp E{(bf16_t*)(ws + WS_R1), ssb, (const LAS float*)(lds + LDS_RS), 0};
            run_gemm(C, lds, xb, (const bf16_t*)(ws + (which ? OFF_GU2 : OFF_GU1)), T_TOK, 2 * FF, DM, E);
            if (C.G == 256 && C.bid >= 128) { Ctx C2 = C; C2.wk = C.bid - 128; C2.nw = 128; phase_convert(C2, layer, lds, which ? 4 : 2); }
        } break;
        case OP_DOWN: case OP_OUT: {
            const bool dn = (op == OP_DOWN);
            float osc = 1.0f;
#ifdef SKIP_EVEN
            if (even) osc = 0.f;
#endif
#ifdef SKIP_ODD
            if (!even) osc = 0.f;
#endif
            float rsc = dn ? 0.5f : osc;
#ifdef REP_MASK
            if (masked && rep == 0) rsc = 0.f;
#endif
            EpiResid E{(ph == N_PHASES - 1) ? P.out : (float*)nullptr, xb, ssb, rsc};
            const bf16_t* A = dn ? (const bf16_t*)(ws + WS_R1) : mixed;
            const bf16_t* Bt = (const bf16_t*)(ws + (dn ? (which ? OFF_D2 : OFF_D1) : OFF_WOUT));
            run_gemm(C, lds, A, Bt, T_TOK, DM, dn ? FF : DM, E);
            if (dn && which && layer < 3 && C.G == 256) phase_convert(C, layer + 1, lds, 1 | 8);
        } break;
        case OP_IN: {
            EpiProj E{(bf16_t*)(ws + WS_R1), ssb, even ? (float*)(ws + WS_DTR) : (float*)nullptr, even ? LDP_E : LDP_O, even ? LDP_E : LDP_O, (const LAS float*)(lds + LDS_RS), 0};
            run_gemm(C, lds, xb, (const bf16_t*)(ws + OFF_WIN), T_TOK, even ? 2304 : 2048, DM, E);
        } break;
#ifndef SKIP_EVEN
        case OP_E1: phase_e1(C, i, lds); break;
#ifdef REP_MASK
        case OP_E2: phase_e2(C, i, rep == 0); break;
#else
        case OP_E2: phase_e2(C, i); break;
#endif
        case OP_E3: phase_e3(C, i, lds); break;
#endif
#ifndef SKIP_EVEN
        case OP_GLU: {
            EpiGlu E{mixed, (const float*)(ws + WS_U2), inp(23) + i * 512};
            run_gemm(C, lds, (const bf16_t*)(ws + WS_U2 + 33554432), (const bf16_t*)(ws + OFF_WX), T_TOK, 512, 512, E);
        } break;
#endif
#ifndef SKIP_ODD
        case OP_O1: phase_o1(C, i, lds); break;
        case OP_O2: phase_o2(C, i, lds); break;
#endif
        }
#ifdef REP_MASK
        if (rep == 0 && masked) continue;
#endif
        if (ph + 1 < P.ph_hi) {
            if (P.ph_hi < 0) grid.sync();
            xcd_barrier(xbar);
#ifdef DOUBLE_BAR
            xcd_barrier(xbar); xcd_barrier(xbar);
#endif
        }
    }
}

extern "C" void kernel_launch(void* const* d_in, const int* in_sizes, int n_in, void* d_out, int out_size, void* d_ws, size_t ws_size, hipStream_t stream) {
    static int grid_blocks = 0;
    if (!grid_blocks) {
        int dev = 0, cus = 0, per_cu = 0;
        hipGetDevice(&dev);
        hipDeviceGetAttribute(&cus, hipDeviceAttributeMultiprocessorCount, dev);
        hipFuncSetAttribute((const void*)fwd_kernel, hipFuncAttributeMaxDynamicSharedMemorySize, LDS_BYTES);
        hipOccupancyMaxActiveBlocksPerMultiprocessor(&per_cu, (const void*)fwd_kernel, 512, LDS_BYTES);
        if (per_cu < 1) per_cu = 1;
        grid_blocks = cus * 1;
        if (n_in != 35 || ws_size < WS_END) fprintf(stderr, "kernel_launch: unexpected n_in %d / ws_size %zu (need %zu)\n", n_in, ws_size, (size_t)WS_END);
    }
    (void)hipMemsetAsync((char*)d_ws + WS_BAR, 0, XCD_BAR_WORDS * 4, stream);
    Params p{};
    for (int k = 0; k < 35; ++k) p.in[k] = (const float*)d_in[k];
    p.out = (float*)d_out; p.ws = (unsigned char*)d_ws; p.ph_lo = 0; p.ph_hi = N_PHASES;
    void* args[] = {&p};
    hipError_t e = hipLaunchCooperativeKernel((const void*)fwd_kernel, dim3(grid_blocks), dim3(512), args, LDS_BYTES, stream);
    if (e != hipSuccess) fprintf(stderr, "cooperative launch failed: %s (grid %d)\n", hipGetErrorString(e), grid_blocks);
}
```
